# Optimizing an MI355X kernel written in HIP

```python
import math
import jax
import jax.numpy as jnp
from jax import lax
import numpy as np


D_MODEL = 1024
BATCH = 4
SEQ = 8192
DEPTH = 1

N_META = 16
EPS = 1e-5
SSD_HEAD_DIM = 64
SSD_WIDTH = D_MODEL
SSD_HEADS = SSD_WIDTH // SSD_HEAD_DIM
SSD_GROUPS = 2
SSD_STATE = 128
SSD_CONV = 4
SSD_CHUNK = 128
GLA_HEADS = 4
GLA_K_WIDTH = D_MODEL // 2
GLA_V_WIDTH = D_MODEL
GLA_KEY_DIM = GLA_K_WIDTH // GLA_HEADS
GLA_VAL_DIM = GLA_V_WIDTH // GLA_HEADS
GLA_RANK = 16
GLA_TAU = 16.0
GLA_CHUNK = 16
MIX_WIDTH = SSD_WIDTH + GLA_V_WIDTH
XBC_WIDTH = SSD_WIDTH + 2 * SSD_GROUPS * SSD_STATE
IN_WIDTH = SSD_WIDTH + XBC_WIDTH + SSD_HEADS + 2 * GLA_K_WIDTH + 2 * GLA_V_WIDTH + GLA_RANK
N_EXPERTS = 32
TOP_K = 4
D_FF = D_MODEL
SWIGLU_LIMIT = 7.0
SWIGLU_ALPHA = 1.702
MOE_BLOCK = 256

kernel_name = "hymba_ssd_gla_moe_block"


def rms_norm(t, w):
    tf = t.astype(jnp.float32)
    tf = tf * lax.rsqrt(jnp.mean(tf * tf, axis=-1, keepdims=True) + EPS)
    return (tf * w.astype(jnp.float32)).astype(t.dtype)


def causal_depthwise_conv(u, w, b):
    c = u.shape[-1]
    out = lax.conv_general_dilated(u, w[:, None, :].astype(u.dtype), window_strides=(1,),
                                   padding=[(SSD_CONV - 1, 0)],
                                   dimension_numbers=('NWC', 'WIO', 'NWC'),
                                   feature_group_count=c)
    return out + b


def ssd_chunked(x, dt, a, bm, cm):
    b, lp, g, hg, p = x.shape
    n = bm.shape[-1]
    nc = lp // SSD_CHUNK
    q = SSD_CHUNK
    x = x.reshape(b, nc, q, g, hg, p)
    dt = dt.reshape(b, nc, q, g, hg)
    bm = bm.reshape(b, nc, q, g, n)
    cm = cm.reshape(b, nc, q, g, n)
    a_cs = jnp.cumsum(dt * a, axis=2)
    dtx = x * dt[..., None]
    acs_t = jnp.moveaxis(a_cs, 2, -1)
    seg = acs_t[..., :, None] - acs_t[..., None, :]
    causal = jnp.tril(jnp.ones((q, q), dtype=bool))
    decay = jnp.exp(jnp.where(causal, seg, -jnp.inf))
    cb = jnp.einsum('bclgn,bcsgn->bcgls', cm, bm)
    y_diag = jnp.einsum('bcghls,bcsghp->bclghp', cb[:, :, :, None] * decay, dtx)
    decay_to_end = jnp.exp(a_cs[:, :, -1:] - a_cs)
    states = jnp.einsum('bcsgn,bcsghp->bcghpn', bm, dtx * decay_to_end[..., None])
    chunk_decay = jnp.exp(a_cs[:, :, -1])

    def step(h, inp):
        dec, st = inp
        return dec[..., None, None] * h + st, h

    h0 = jnp.zeros((b, g, hg, p, n), states.dtype)
    _, h_prev = lax.scan(step, h0, (jnp.moveaxis(chunk_decay, 1, 0), jnp.moveaxis(states, 1, 0)))
    h_prev = jnp.moveaxis(h_prev, 0, 1)
    y_off = jnp.einsum('bclgn,bcghpn->bclghp', cm, h_prev) * jnp.exp(a_cs)[..., None]
    return (y_diag + y_off).reshape(b, lp, g, hg, p)


def gla_chunked(q, k, v, log_a):
    b, l, h, dk = q.shape
    dv = v.shape[-1]
    nc = l // GLA_CHUNK
    c = GLA_CHUNK
    q = q.reshape(b, nc, c, h, dk)
    k = k.reshape(b, nc, c, h, dk)
    v = v.reshape(b, nc, c, h, dv)
    g_cs = jnp.cumsum(log_a.reshape(b, nc, c, h, dk), axis=2)
    q_dec = q * jnp.exp(g_cs)
    k_inv = k * jnp.exp(-g_cs)
    k_end = k * jnp.exp(g_cs[:, :, -1:] - g_cs)
    causal = jnp.tril(jnp.ones((c, c), dtype=bool))
    scores = jnp.einsum('bclhd,bcshd->bchls', q_dec, k_inv)
    o_intra = jnp.einsum('bchls,bcshv->bclhv', jnp.where(causal, scores, 0.0), v)
    chunk_decay = jnp.exp(g_cs[:, :, -1])

    def step(s, inp):
        qd, ke, vc, dec = inp
        o = jnp.einsum('blhd,bhdv->blhv', qd, s)
        s = dec[..., None] * s + jnp.einsum('blhd,blhv->bhdv', ke, vc)
        return s, o

    s0 = jnp.zeros((b, h, dk, dv), jnp.float32)
    _, o_inter = lax.scan(step, s0, (jnp.moveaxis(q_dec, 1, 0), jnp.moveaxis(k_end, 1, 0),
                                     jnp.moveaxis(v, 1, 0), jnp.moveaxis(chunk_decay, 1, 0)))
    o = o_intra + jnp.moveaxis(o_inter, 0, 1)
    return o.reshape(b, l, h, dv)


def hybrid_mixer(u, w_in, conv_w, conv_b, dt_bias, a_log, d_skip, ssd_norm_w,
                 w_decay_up, b_decay, gla_norm_w, w_out):
    b, l, _ = u.shape
    proj = u @ w_in
    cuts = np.cumsum([SSD_WIDTH, XBC_WIDTH, SSD_HEADS, GLA_K_WIDTH, GLA_K_WIDTH,
                      GLA_V_WIDTH, GLA_V_WIDTH]).tolist()
    z, xbc, dt_raw, q, k, v, g_out, a_lr = jnp.split(proj, cuts, axis=-1)

    xbc = jax.nn.silu(causal_depthwise_conv(xbc, conv_w, conv_b))
    xs, bm, cm = jnp.split(xbc, [SSD_WIDTH, SSD_WIDTH + SSD_GROUPS * SSD_STATE], axis=-1)
    dt = jax.nn.softplus(dt_raw.astype(jnp.float32) + dt_bias.astype(jnp.float32))
    a = -jnp.exp(a_log.astype(jnp.float32))
    pad = SSD_CHUNK - N_META
    lp = l + pad
    hg = SSD_HEADS // SSD_GROUPS

    def pad_front(t):
        return jnp.pad(t, ((0, 0), (pad, 0)) + ((0, 0),) * (t.ndim - 2))

    y = ssd_chunked(pad_front(xs).reshape(b, lp, SSD_GROUPS, hg, SSD_HEAD_DIM),
                    pad_front(dt).reshape(b, lp, SSD_GROUPS, hg),
                    a.reshape(SSD_GROUPS, hg),
                    pad_front(bm).reshape(b, lp, SSD_GROUPS, SSD_STATE),
                    pad_front(cm).reshape(b, lp, SSD_GROUPS, SSD_STATE))
    y = y[:, pad:].reshape(b, l, SSD_HEADS, SSD_HEAD_DIM) \
        + d_skip[:, None] * xs.reshape(b, l, SSD_HEADS, SSD_HEAD_DIM)
    gsz = SSD_WIDTH // SSD_GROUPS
    y = y.reshape(b, l, SSD_GROUPS, gsz) * jax.nn.silu(z).reshape(b, l, SSD_GROUPS, gsz)
    y_ssd = rms_norm(y, ssd_norm_w.reshape(SSD_GROUPS, gsz)).reshape(b, l, SSD_WIDTH)

    log_a = jax.nn.log_sigmoid((a_lr @ w_decay_up + b_decay).astype(jnp.float32)) / GLA_TAU
    o = gla_chunked((q * GLA_KEY_DIM ** -0.5).reshape(b, l, GLA_HEADS, GLA_KEY_DIM),
                    k.reshape(b, l, GLA_HEADS, GLA_KEY_DIM),
                    v.reshape(b, l, GLA_HEADS, GLA_VAL_DIM),
                    log_a.reshape(b, l, GLA_HEADS, GLA_KEY_DIM))
    o = rms_norm(o, gla_norm_w) * jax.nn.silu(g_out.astype(jnp.float32)).reshape(b, l, GLA_HEADS, GLA_VAL_DIM)
    y_gla = o.reshape(b, l, GLA_V_WIDTH)

    mixed = jnp.concatenate([y_ssd.astype(u.dtype), y_gla.astype(u.dtype)], axis=-1)
    return mixed @ w_out


def moe_ffn(t, w_router, b_router, w_gate_up, b_gate_up, w_down, b_down):
    n, d = t.shape
    logits = (t @ w_router + b_router).astype(jnp.float32)
    top_logits, top_idx = lax.top_k(logits, TOP_K)
    gates = jax.nn.softmax(top_logits, axis=-1)
    m = n * TOP_K
    expert_flat = top_idx.reshape(m)
    order = jnp.argsort(expert_flat)
    expert_sorted = expert_flat[order]
    counts = jnp.bincount(expert_flat, length=N_EXPERTS)
    padded = (counts + MOE_BLOCK - 1) // MOE_BLOCK * MOE_BLOCK
    start = jnp.cumsum(counts) - counts
    pend = jnp.cumsum(padded)
    pstart = pend - padded
    dest_sorted = (pstart[expert_sorted] + jnp.arange(m) - start[expert_sorted]).astype(jnp.int32)
    n_blocks = -(-m // MOE_BLOCK) + N_EXPERTS
    rows = n_blocks * MOE_BLOCK
    src_token = jnp.full((rows,), n, jnp.int32).at[dest_sorted].set((order // TOP_K).astype(jnp.int32))
    t_pad = jnp.concatenate([t, jnp.zeros((1, d), t.dtype)], axis=0)
    buf = t_pad[src_token].reshape(n_blocks, MOE_BLOCK, d)
    block_expert = jnp.minimum(jnp.searchsorted(pend, jnp.arange(n_blocks) * MOE_BLOCK, side='right'),
                               N_EXPERTS - 1)

    def expert_block(args):
        xb, e = args
        hgu = xb @ w_gate_up[e] + b_gate_up[e]
        gate, up = jnp.split(hgu, 2, axis=-1)
        gate = jnp.minimum(gate, SWIGLU_LIMIT)
        up = jnp.clip(up, -SWIGLU_LIMIT, SWIGLU_LIMIT)
        act = gate * jax.nn.sigmoid(SWIGLU_ALPHA * gate)
        return ((up + 1.0) * act) @ w_down[e] + b_down[e]

    y_buf = lax.map(expert_block, (buf, block_expert)).reshape(rows, d)
    dest = jnp.zeros((m,), jnp.int32).at[order].set(dest_sorted)
    y = y_buf[dest].reshape(n, TOP_K, d)
    return jnp.einsum('nk,nkd->nd', gates.astype(t.dtype), y)


def setup_inputs(seed: int = 0) -> dict:
    key = jax.random.key(seed)
    ks = jax.random.split(key, 24)
    f32 = jnp.float32
    nrm = lambda k, shape, scale: jax.random.normal(k, shape, f32) * scale
    dt = jnp.exp(jax.random.uniform(ks[6], (DEPTH, SSD_HEADS), f32)
                 * (math.log(0.1) - math.log(1e-3)) + math.log(1e-3))
    return {
        'x': nrm(ks[0], (BATCH, SEQ, D_MODEL), 1.0),
        'meta_tokens': nrm(ks[1], (N_META, D_MODEL), 1.0),
        'mix_norm_w': 1.0 + nrm(ks[2], (DEPTH, D_MODEL), 0.02),
        'w_in': nrm(ks[3], (DEPTH, D_MODEL, IN_WIDTH), D_MODEL ** -0.5),
        'conv_w': nrm(ks[4], (DEPTH, SSD_CONV, XBC_WIDTH), SSD_CONV ** -0.5),
        'conv_b': nrm(ks[5], (DEPTH, XBC_WIDTH), 0.01),
        'dt_bias': dt + jnp.log(-jnp.expm1(-dt)),
        'a_log': jnp.log(jax.random.uniform(ks[7], (DEPTH, SSD_HEADS), f32, 1.0, 16.0)),
        'd_skip': 1.0 + nrm(ks[8], (DEPTH, SSD_HEADS), 0.1),
        'ssd_norm_w': 1.0 + nrm(ks[9], (DEPTH, SSD_WIDTH), 0.02),
        'w_decay_up': nrm(ks[10], (DEPTH, GLA_RANK, GLA_K_WIDTH), GLA_RANK ** -0.5),
        'b_decay': nrm(ks[11], (DEPTH, GLA_K_WIDTH), 0.01),
        'gla_norm_w': 1.0 + nrm(ks[12], (DEPTH, GLA_VAL_DIM), 0.02),
        'w_out': nrm(ks[13], (DEPTH, MIX_WIDTH, D_MODEL), MIX_WIDTH ** -0.5),
        'ffn_norm_w': 1.0 + nrm(ks[14], (DEPTH, D_MODEL), 0.02),
        'w_router': nrm(ks[15], (DEPTH, D_MODEL, N_EXPERTS), D_MODEL ** -0.5),
        'b_router': nrm(ks[16], (DEPTH, N_EXPERTS), 0.01),
        'w_gate_up': nrm(ks[17], (DEPTH, N_EXPERTS, D_MODEL, 2 * D_FF), D_MODEL ** -0.5),
        'b_gate_up': nrm(ks[18], (DEPTH, N_EXPERTS, 2 * D_FF), 0.01),
        'w_down': nrm(ks[19], (DEPTH, N_EXPERTS, D_FF, D_MODEL), D_FF ** -0.5),
        'b_down': nrm(ks[20], (DEPTH, N_EXPERTS, D_MODEL), 0.01),
        'final_norm_w': 1.0 + nrm(ks[21], (D_MODEL,), 0.02),
    }


def reference(x, meta_tokens, mix_norm_w, w_in, conv_w, conv_b, dt_bias, a_log, d_skip,
              ssd_norm_w, w_decay_up, b_decay, gla_norm_w, w_out, ffn_norm_w, w_router,
              b_router, w_gate_up, b_gate_up, w_down, b_down, final_norm_w):
    b = x.shape[0]
    meta = jnp.broadcast_to(meta_tokens[None].astype(x.dtype), (b, N_META, D_MODEL))
    h = jnp.concatenate([meta, x], axis=1)
    for i in range(DEPTH):
        h = h + hybrid_mixer(rms_norm(h, mix_norm_w[i]), w_in[i], conv_w[i], conv_b[i],
                             dt_bias[i], a_log[i], d_skip[i], ssd_norm_w[i], w_decay_up[i],
                             b_decay[i], gla_norm_w[i], w_out[i])
        if i == DEPTH - 1:
            h = h[:, N_META:]
        bb, ll, dd = h.shape
        ffn = moe_ffn(rms_norm(h, ffn_norm_w[i]).reshape(bb * ll, dd), w_router[i], b_router[i],
                      w_gate_up[i], b_gate_up[i], w_down[i], b_down[i])
        h = h + ffn.reshape(bb, ll, dd)
    return rms_norm(h, final_norm_w)
```

```cpp
#include <hip/hip_runtime.h>
#include <cstdio>
#include <cstdint>

#define GAS __attribute__((address_space(1)))
#define LAS __attribute__((address_space(3)))
typedef unsigned short bf16;
typedef float f32x4 __attribute__((ext_vector_type(4)));
typedef float f32x2 __attribute__((ext_vector_type(2)));
typedef short bf16x8 __attribute__((ext_vector_type(8)));
typedef unsigned u32x4 __attribute__((ext_vector_type(4)));
typedef unsigned u32x2 __attribute__((ext_vector_type(2)));

constexpr int BATCH = 4, SEQ = 8192, D = 1024, NMETA = 16;
constexpr int LPAD = 8320;
constexpr int PADROWS = 112, REAL0 = 128;
constexpr int MROWS = BATCH * LPAD;
constexpr int NTOK = BATCH * SEQ;
constexpr int INW = 5664, INWP = 5888;
constexpr int C_Z = 0, C_XBC = 1024, C_XS = 1024, C_B = 2048, C_C = 2304, C_DT = 2560, C_Q = 2576, C_K = 3088, C_V = 3600, C_G = 4624, C_ALR = 5648;
constexpr int XBCW = 1536, MIXW = 2048;
constexpr int NEXP = 32, TOPK = 4, DFF = 1024;
constexpr int MAXMT = 544;
constexpr int ACTROWS = MAXMT * 256;
constexpr float EPS = 1e-5f;

constexpr size_t MiB = 1u << 20;
constexpr size_t WS_CTL = 0, CTL_ZERO_BYTES = 1 * MiB;
constexpr size_t WS_WIN = 1 * MiB;
constexpr size_t WS_WOUT = 13 * MiB;
constexpr size_t WS_WGU = 17 * MiB;
constexpr size_t WS_WDN = 145 * MiB;
constexpr size_t WS_R1 = 209 * MiB;
constexpr size_t WS_R2 = 583 * MiB;
constexpr size_t WS_PROJ = WS_R1, WS_ACT = WS_R1;
constexpr size_t WS_MIXRAW = WS_R2;
constexpr size_t WS_SST = WS_R2;
constexpr size_t WS_GST = WS_R2 + 65 * MiB;
constexpr size_t WS_MIXED = WS_R2 + 260 * MiB;
constexpr size_t WS_T = WS_R2;
constexpr size_t WS_YPAIR = WS_R2 + 32 * MiB;
constexpr size_t WS_H1B = WS_R2 + 168 * MiB;
constexpr size_t WS_END = 1024 * MiB;
static_assert(WS_MIXED + (size_t)MROWS * MIXW * 2 <= WS_END && WS_YPAIR + (size_t)ACTROWS * D * 2 <= WS_END && WS_PROJ + (size_t)MROWS * INWP * 2 <= WS_R2, "ws map");
constexpr int CW_CNT = 1024;
constexpr int CW_Q = 2048;
constexpr int CW_BAR = 4096;
constexpr size_t WS_GATES = WS_CTL + 0;
constexpr size_t WS_TAB = WS_R2 + 400 * MiB;
constexpr size_t TAB_GATES = 0, TAB_PE = 512 * 1024, TAB_PS = 1024 * 1024, TAB_LIST = 2 * MiB;
constexpr size_t TAB_CDEC = 6 * MiB, TAB_GDEC = 6 * MiB + 256 * 1024;
static_assert(WS_YPAIR + (size_t)ACTROWS * D <= WS_H1B && WS_H1B + (size_t)NTOK * D * 2 <= WS_MIXED && WS_T + (size_t)NTOK * D <= WS_YPAIR, "h1 map");
static_assert(WS_TAB + 8 * MiB <= WS_END && WS_YPAIR + (size_t)ACTROWS * D * 2 <= WS_TAB && WS_MIXED + (size_t)MROWS * MIXW * 2 <= WS_TAB, "tab map");

constexpr int RING_BYTES = 131072;
constexpr int LDS_BYTES = 147456;
constexpr int MISC_OFF = RING_BYTES;

__host__ __device__ __forceinline__ size_t paddr(long row, int col) {
    const int r = (int)(row & 255), c = col & 255;
    return ((size_t)((row >> 8) * 23 + (col >> 8)) * 131072 + ((((r >> 6) & 1) * 4 + ((c >> 5) & 3)) * 16 + ((r >> 7) * 4 + ((r >> 4) & 3)) * 2 + (c >> 7)) * 1024 + ((c >> 3) & 3) * 256 + (r & 15) * 16 + (c & 7) * 2) >> 1;
}
__host__ __device__ __forceinline__ constexpr int prow16(int k) { return ((k >> 2) * 65536 + (k & 3) * 2048) >> 1; }
__device__ __forceinline__ float bf2f(bf16 b) { return __uint_as_float(((unsigned)b) << 16); }
__device__ __forceinline__ unsigned f2bf(float f) { unsigned u = __float_as_uint(f); return (u + 0x7fffu + ((u >> 16) & 1u)) >> 16; }
typedef __bf16 bf16x2_t __attribute__((ext_vector_type(2)));
__device__ __forceinline__ unsigned pk2(float lo, float hi) { const f32x2 v = {lo, hi}; return __builtin_bit_cast(unsigned, __builtin_convertvector(v, bf16x2_t)); }
__device__ __forceinline__ unsigned pk4_fp8(float a, float b, float c, float d) { unsigned w = 0; w = __builtin_amdgcn_cvt_pk_fp8_f32(a, b, w, false); w = __builtin_amdgcn_cvt_pk_fp8_f32(c, d, w, true); return w; }
constexpr float W8_SCALE = 64.f;
constexpr int SCALE_HALF = 0x7C7C7C7C;
__device__ __forceinline__ float wave_sum(float v) {
#pragma unroll
    for (int o = 1; o < 64; o <<= 1) v += __shfl_xor(v, o);
    return v;
}
__device__ __forceinline__ float wave_max(float v) {
#pragma unroll
    for (int o = 1; o < 64; o <<= 1) v = fmaxf(v, __shfl_xor(v, o));
    return v;
}
__device__ __forceinline__ void sync_lds() { asm volatile("s_waitcnt lgkmcnt(0)\n\ts_barrier" ::: "memory"); }
__device__ __forceinline__ int draw(unsigned* head) { return (int)atomicInc(head, 0xFFFFFFFFu); }
__device__ __forceinline__ float silu_f(float x) { return x * __builtin_amdgcn_rcpf(1.f + __expf(-x)); }
__device__ __forceinline__ float softplus_f(float x) { return fmaxf(x, 0.f) + __logf(1.f + __expf(-fabsf(x))); }
__device__ __forceinline__ float logsigmoid_f(float x) { return fminf(x, 0.f) - __logf(1.f + __expf(-fabsf(x))); }


typedef GAS unsigned gu32;
#define XB_TMO      128
#define XB_XCNT(j)  (256  + 64 * (j))
#define XB_XSUB(j)  (1280 + 64 * (j))
#define XB_XGEN(j)  (2304 + 64 * (j))
#define XB_TOP      3328
#define XB_TOPGEN   3392
#define XCD_BAR_WORDS 3456
#define XB_SPIN_CAP (1u << 18)
__device__ __forceinline__ unsigned xb_ld(unsigned* p)              { return __hip_atomic_load(p, __ATOMIC_RELAXED, __HIP_MEMORY_SCOPE_AGENT); }
__device__ __forceinline__ unsigned xb_add(unsigned* p, unsigned v) { return __hip_atomic_fetch_add(p, v, __ATOMIC_RELAXED, __HIP_MEMORY_SCOPE_AGENT); }
__device__ __forceinline__ unsigned xb_xcc_id() { return (unsigned)__builtin_amdgcn_s_getreg((3 << 11) | 20) & 0xFu; }
#define XB_SPIN(cond, bar) do { unsigned _sp = 0; while (cond) { __builtin_amdgcn_s_sleep(1); \
    if ((++_sp & 255u) == 0u) { if (xb_ld(&(bar)[XB_TMO])) break; if (_sp > XB_SPIN_CAP) { atomicAdd(&(bar)[XB_TMO], 1u); break; } } } } while (0)
struct XcdBarrier { unsigned* bar; unsigned x; volatile LAS unsigned* st; };
__device__ __forceinline__ XcdBarrier xcd_barrier_post(unsigned* bar, volatile LAS unsigned* st) {
    XcdBarrier b; b.bar = bar; b.x = xb_xcc_id(); b.st = st;
    if (threadIdx.x == 0) (void)xb_add(&bar[XB_XCNT(b.x)], 1u);
    return b;
}
__device__ __forceinline__ void xcd_barrier_complete(unsigned* bar, unsigned x, unsigned& nloc, unsigned& nx) {
    const unsigned G = gridDim.x * gridDim.y * gridDim.z;
    unsigned sum, cnt, mine, sp = 0u;
    for (;;) {
        sum = 0u; cnt = 0u; mine = 0u;
#pragma unroll
        for (unsigned j = 0; j < 16; ++j) { const unsigned c = xb_ld(&bar[XB_XCNT(j)]); sum += c; cnt += (c > 0u) ? 1u : 0u; mine = (j == x) ? c : mine; }
        if (sum == G) break;
        __builtin_amdgcn_s_sleep(1);
        if ((++sp & 255u) == 0u) { if (xb_ld(&bar[XB_TMO])) break; if (sp > XB_SPIN_CAP) { atomicAdd(&bar[XB_TMO], 1u); break; } }
    }
    nloc = mine > 0u ? mine : 1u; nx = cnt > 0u ? cnt : 1u;
}
__device__ __forceinline__ void xcd_barrier(const XcdBarrier& b) {
    asm volatile("s_waitcnt vmcnt(0)" ::: "memory");
    __syncthreads();
    if (threadIdx.x == 0) {
        unsigned* bar = b.bar;
        __builtin_amdgcn_s_waitcnt(0);
        unsigned nloc = b.st[0], nx = b.st[1];
        if (nloc == 0u) { xcd_barrier_complete(bar, b.x, nloc, nx); b.st[0] = nloc; b.st[1] = nx; }
        const unsigned old = xb_add(&bar[XB_XSUB(b.x)], 1u);
        const unsigned gen = old / nloc;
        if (old + 1u == (gen + 1u) * nloc) {
            __builtin_amdgcn_fence(__ATOMIC_RELEASE, "agent");
            asm volatile("s_waitcnt vmcnt(0)" ::: "memory");
            const unsigned og = xb_add(&bar[XB_TOP], 1u);
            const unsigned tg = og / nx;
            if (og + 1u == (tg + 1u) * nx) xb_add(&bar[XB_TOPGEN], 1u);
            else XB_SPIN(xb_ld(&bar[XB_TOPGEN]) == tg, bar);
            __builtin_amdgcn_fence(__ATOMIC_ACQUIRE, "agent");
            xb_add(&bar[XB_XGEN(b.x)], 1u);
            asm volatile("s_waitcnt vmcnt(0)" ::: "memory");
        } else {
            XB_SPIN(xb_ld(&bar[XB_XGEN(b.x)]) == gen, bar);
            __builtin_amdgcn_fence(__ATOMIC_ACQUIRE, "agent");
            asm volatile("s_waitcnt vmcnt(0)" ::: "memory");
        }
    }
    __syncthreads();
}

namespace pg8 {
#define PG8_LAS __attribute__((address_space(3)))
typedef unsigned short bf16_t;
typedef int v8i_t __attribute__((ext_vector_type(8)));
typedef int v4i_t __attribute__((ext_vector_type(4)));
constexpr int BM = 256, BK = 64, HALF = 128, HTB = HALF * BK * 2, STAGE_BYTES = 8 * HTB, NXCD = 8;
__host__ __device__ __forceinline__ int lds_byte(int r, int c) { const int st = (r >> 4) * 2 + (c >> 5), rr = r & 15, cc = c & 31, ob = rr * 64 + cc * 2; return st * 1024 + (ob ^ (((ob >> 9) & 1) << 5)); }
__host__ __device__ __forceinline__ void stage_rc(int b, int& R, int& C) { const int st = b / 1024, sb = b % 1024, swz = sb ^ (((sb >> 9) & 1) << 5); R = (st >> 1) * 16 + swz / 64; C = (st & 1) * 32 + (swz % 64) / 2; }
__host__ __device__ __forceinline__ int perm32(int rho) { const int n = rho >> 4, i = rho & 15; return 8 * (i >> 2) + 4 * n + (i & 3); }

struct Unit { const char* A; const char* B; int pm, pn, e; unsigned bias_lds; };

__device__ __forceinline__ bool static_order(int i, int G, int c, int nM, int nN, int WGM, int& pm, int& pn) {
    const int nwg = nM * nN; const long L = (long)i * G + c; if (L >= nwg) return false;
    int wgid = (int)L; { const int q = nwg / NXCD, r = nwg % NXCD, xcd = wgid % NXCD, off = wgid / NXCD; wgid = (xcd < r ? xcd * (q + 1) : r * (q + 1) + (xcd - r) * q) + off; }
    const int nig = WGM * nN, gid = wgid / nig, fm = gid * WGM, gsz = (nM - fm) < WGM ? (nM - fm) : WGM;
    const int w = wgid % nig;
    if (gsz == WGM) { pm = fm + (w % WGM); pn = w / WGM; } else { pm = fm + (w % gsz); pn = w / gsz; }
    return true;
}

__device__ __forceinline__ void mfma_fp8(f32x4& acc, const v8i_t& w, const v8i_t& a) {
    asm volatile("s_nop 1\n\tv_mfma_scale_f32_16x16x128_f8f6f4 %0, %1, %2, %0, %3, %3 op_sel_hi:[0,0,0]" : "+v"(acc) : "v"(w), "v"(a), "v"(SCALE_HALF));
}
__device__ __forceinline__ unsigned cvt_pk_bf16(float lo, float hi) { unsigned r; asm volatile("v_cvt_pk_bf16_f32 %0, %1, %2" : "=v"(r) : "v"(lo), "v"(hi)); return r; }

#ifndef SIMPLE_GEMM
#define SIMPLE_GEMM 0
#endif
#ifndef RELAX_EPI
#define RELAX_EPI 0
#endif

template <class Epi, class Sched, bool GATHER, bool FP8 = false>
__device__ __forceinline__ void gemm_phase(PG8_LAS unsigned char* lds, const int K, const Sched& S, const Epi& E) {
    const int tid = threadIdx.x, wid = __builtin_amdgcn_readfirstlane(tid >> 6), lane = tid & 63, wr = wid >> 2, wc = wid & 3, fr = lane & 15, fq = lane >> 4;
#if SIMPLE_GEMM
    Unit cur;
    for (int ui = 0; S.next(ui, cur); ++ui) {
        f32x4 acc[2][2][4][2];
#pragma unroll
        for (int a = 0; a < 2; ++a)
#pragma unroll
            for (int b = 0; b < 2; ++b)
#pragma unroll
                for (int m = 0; m < 4; ++m)
#pragma unroll
                    for (int n = 0; n < 2; ++n) acc[a][b][m][n] = (f32x4){0.f, 0.f, 0.f, 0.f};
        for (int ai = 0; ai < 2; ++ai)
            for (int m = 0; m < 4; ++m) {
                unsigned vo[2][2]; S.a_offs(cur, vo, (wr * 64 + m * 16 + fr) * 4  );
                const char* arow = cur.A + vo[ai][0];
                for (int bj = 0; bj < 2; ++bj)
                    for (int n = 0; n < 2; ++n) {
                        const int brl = wc * 32 + (Epi::CMAP == 1 ? perm32(16 * n + fr) : 16 * n + fr);
                        const char* brow = cur.B + (size_t)(bj * HALF + brl) * K * 2;
                        f32x4 c = acc[ai][bj][m][n];
                        for (int k = 0; k < K; k += 32) {
                            const bf16x8 af = *(const bf16x8*)(arow + (size_t)(k + 8 * fq) * 2);
                            const bf16x8 bfv = *(const bf16x8*)(brow + (size_t)(k + 8 * fq) * 2);
                            c = __builtin_amdgcn_mfma_f32_16x16x32_bf16(bfv, af, c, 0, 0, 0);
                        }
                        acc[ai][bj][m][n] = c;
                    }
            }
        E(acc, cur, wr, wc, fr, fq);
    }
    __syncthreads();
#else
    const int nt = K / BK;
    constexpr bool RLX_ON = RELAX_EPI && !GATHER;
    unsigned voffB[Epi::CMAP == 2 ? 2 : 1][2];
#pragma unroll
    for (int i = 0; i < 2; ++i) { int R_, C_; stage_rc(tid * 16 + i * 8192, R_, C_);
        if constexpr (Epi::CMAP == 2) {
#pragma unroll
            for (int h = 0; h < 2; ++h) { const int Rb = 64 * (R_ >> 5) + 16 * ((R_ & 15) >> 2) + 8 * h + 4 * ((R_ >> 4) & 1) + (R_ & 3); voffB[h][i] = (unsigned)(Rb * K + C_) * 2u; } }
        else { const int Rb = Epi::CMAP == 1 ? ((R_ & ~31) + perm32(R_ & 31)) : R_; voffB[0][i] = (unsigned)(Rb * K + C_) * 2u; } }
#define PG8_STB(h, kb, gb) do { if constexpr (Epi::CMAP == 2) PG8_STAGE(PG8_SB(kb, h), (gb), voffB[h][0], voffB[h][1]); else PG8_STAGE(PG8_SB(kb, h), (gb) + (h) * hstep, voffB[0][0], voffB[0][1]); } while (0)
    const size_t kstep = (size_t)(BK * 2);
    const size_t hstep = (size_t)HALF * K * 2;
    const unsigned ldsw = (unsigned)wid * 1024u;
    const int aoff = lds_byte(wr * 64 + fr, fq * 8), boff = lds_byte(wc * 32 + fr, fq * 8);
#define PG8_SA(b, h) (((b) * 2 + (h)) * HTB)
#define PG8_SB(b, h) ((4 + (b) * 2 + (h)) * HTB)
#define PG8_GL(gp, ldsoff) __builtin_amdgcn_global_load_lds((const unsigned*)(gp), (PG8_LAS unsigned*)(lds + (ldsoff)), 16, 0, 0)
#define PG8_STAGE(bufoff, gbase, v0, v1) do { PG8_GL((const char*)(gbase) + (v0), (bufoff) + ldsw); PG8_GL((const char*)(gbase) + (v1), (bufoff) + ldsw + 8192); } while (0)
#define PG8_LD8(off) __builtin_shufflevector(*(const PG8_LAS v4i_t*)(lds + (off)), *(const PG8_LAS v4i_t*)(lds + (off) + 1024), 0, 1, 2, 3, 4, 5, 6, 7)
#define PG8_LDA(dst, b, h) do { if constexpr (FP8) { _Pragma("unroll") for (int m = 0; m < 4; ++m) dst##8[m] = PG8_LD8(PG8_SA(b, h) + aoff + m * 2048); } \
        else { _Pragma("unroll") for (int m = 0; m < 4; ++m) _Pragma("unroll") for (int k = 0; k < 2; ++k) dst[m][k] = *(const PG8_LAS bf16x8*)(lds + PG8_SA(b, h) + aoff + m * 2048 + k * 1024); } } while (0)
#define PG8_LDB(dst, b, h) do { if constexpr (FP8) { _Pragma("unroll") for (int n = 0; n < 2; ++n) dst##8[n] = PG8_LD8(PG8_SB(b, h) + boff + n * 2048); } \
        else { _Pragma("unroll") for (int n = 0; n < 2; ++n) _Pragma("unroll") for (int k = 0; k < 2; ++k) dst[n][k] = *(const PG8_LAS bf16x8*)(lds + PG8_SB(b, h) + boff + n * 2048 + k * 1024); } } while (0)
#define PG8_MMA(ai, bj, At, Bt) do { __builtin_amdgcn_s_setprio(1); \
        if constexpr (FP8) { _Pragma("unroll") for (int m = 0; m < 4; ++m) _Pragma("unroll") for (int n = 0; n < 2; ++n) \
            mfma_fp8(acc[ai][bj][m][n], Bt##8[n], At##8[m]); } \
        else { _Pragma("unroll") for (int m = 0; m < 4; ++m) _Pragma("unroll") for (int n = 0; n < 2; ++n) _Pragma("unroll") for (int k = 0; k < 2; ++k) \
            acc[ai][bj][m][n] = __builtin_amdgcn_mfma_f32_16x16x32_bf16(Bt[n][k], At[m][k], acc[ai][bj][m][n], 0, 0, 0); } \
        __builtin_amdgcn_s_setprio(0); } while (0)
#define PG8_WAIT_V(n) asm volatile("s_waitcnt vmcnt(" #n ")" ::: "memory")
#define PG8_WAIT_L(n) asm volatile("s_waitcnt lgkmcnt(" #n ")" ::: "memory")
#define PG8_BAR __builtin_amdgcn_s_barrier()
#define PG8_SCHED __builtin_amdgcn_sched_barrier(0)
    Unit cur, nxt; int ui = 0;
    if (!S.next(0, cur)) return;
    f32x4 acc[2][2][4][2];
#pragma unroll
    for (int a = 0; a < 2; ++a)
#pragma unroll
        for (int b = 0; b < 2; ++b)
#pragma unroll
            for (int m = 0; m < 4; ++m)
#pragma unroll
                for (int n = 0; n < 2; ++n) acc[a][b][m][n] = (f32x4){0.f, 0.f, 0.f, 0.f};
    bf16x8 At[4][2], B0[2][2], B1[2][2];
    v8i_t At8[4], B08[2], B18[2];
    unsigned vAc[2][2], vAn[2][2];
    S.a_offs(cur, vAc, tid);
    const char* cA = cur.A; const char* cB = cur.B;
#define PG8_BIAS_DMA(u, par) do { if constexpr (Epi::LDS_BIAS) { (u).bias_lds = (unsigned)(STAGE_BYTES + 2048 + (par) * 1024); \
        if (wid == 0) { int bl_ = lane; asm volatile("" : "+v"(bl_)); __builtin_amdgcn_global_load_lds((const unsigned*)S.bias_src((u), bl_), (PG8_LAS unsigned*)(lds + STAGE_BYTES + 2048 + (par) * 1024), 16, 0, 0); } } } while (0)
    PG8_BIAS_DMA(cur, 0);
    if constexpr (Epi::BIAS_INIT) {
        PG8_WAIT_V(0); PG8_BAR; int et = threadIdx.x; asm volatile("" : "+v"(et)); E.init(acc, cur, wc, (et >> 4) & 3); }
    PG8_STB(0, 0, cB); PG8_STB(1, 0, cB); PG8_STAGE(PG8_SA(0, 0), cA, vAc[0][0], vAc[0][1]); PG8_STAGE(PG8_SA(0, 1), cA, vAc[1][0], vAc[1][1]);
    if (wr == 1) PG8_BAR;
    PG8_WAIT_V(2); PG8_BAR;
    PG8_STB(0, 1, cB + kstep); PG8_STAGE(PG8_SA(1, 0), cA + kstep, vAc[0][0], vAc[0][1]); PG8_STB(1, 1, cB + kstep);
    PG8_WAIT_V(6); PG8_BAR;
    for (;;) {
        const bool has_next = S.next(ui + 1, nxt);
        const char* nA = has_next ? nxt.A : cA; const char* nB = has_next ? nxt.B : cB;
        if constexpr (Epi::BIAS_INIT) { if (has_next) PG8_BIAS_DMA(nxt, (ui + 1) & 1); }
        if constexpr (GATHER) {
            if (has_next) S.a_offs(nxt, vAn, tid);
            else { vAn[0][0] = vAc[0][0]; vAn[0][1] = vAc[0][1]; vAn[1][0] = vAc[1][0]; vAn[1][1] = vAc[1][1]; }
        }
#define PG8_KITER(RLX) do { \
            const bool last = (t == nt - 2); \
            const char* a1 = cA + (size_t)(t + 1) * kstep; \
            const char* a2 = last ? nA : cA + (size_t)(t + 2) * kstep; const char* b2 = last ? nB : cB + (size_t)(t + 2) * kstep; \
            const char* a3 = a2 + kstep; const char* b3 = b2 + kstep; \
            unsigned o00 = vAc[0][0], o01 = vAc[0][1], o10 = vAc[1][0], o11 = vAc[1][1]; \
            if constexpr (GATHER) { if (last) { o00 = vAn[0][0]; o01 = vAn[0][1]; o10 = vAn[1][0]; o11 = vAn[1][1]; } } \
              \
            PG8_LDB(B0, 0, 0); PG8_LDB(B1, 0, 1); PG8_SCHED; PG8_LDA(At, 0, 0); if (!(RLX)) PG8_STAGE(PG8_SA(1, 1), a1, vAc[1][0], vAc[1][1]); \
            PG8_WAIT_VN((RLX) ? 8 + Epi::NST : 8); PG8_WAIT_L(0); PG8_BAR; PG8_MMA(0, 0, At, B0); PG8_MMA(0, 1, At, B1); PG8_BAR; PG8_SCHED; \
              \
            PG8_LDA(At, 0, 1); PG8_STB(0, 0, b2); PG8_STB(1, 0, b2); PG8_STAGE(PG8_SA(0, 0), a2, o00, o01); \
            PG8_WAIT_VN((RLX) ? 8 + Epi::NST : 8); PG8_WAIT_L(0); PG8_BAR; PG8_MMA(1, 0, At, B0); PG8_MMA(1, 1, At, B1); PG8_BAR; PG8_SCHED; \
              \
            PG8_LDB(B0, 1, 0); PG8_LDB(B1, 1, 1); PG8_SCHED; PG8_LDA(At, 1, 0); PG8_STAGE(PG8_SA(0, 1), a2, o10, o11); \
            PG8_WAIT_VN((RLX) ? 8 + Epi::NST : 8); PG8_WAIT_L(0); PG8_BAR; PG8_MMA(0, 0, At, B0); PG8_MMA(0, 1, At, B1); PG8_BAR; PG8_SCHED; \
              \
            PG8_LDA(At, 1, 1); PG8_STB(0, 1, b3); PG8_STB(1, 1, b3); PG8_STAGE(PG8_SA(1, 0), a3, o00, o01); \
            PG8_WAIT_VN(8); PG8_WAIT_L(0); PG8_BAR; PG8_MMA(1, 0, At, B0); \
            if constexpr (Epi::SPLIT) { if (last) { PG8_SCHED; if constexpr (FP8) asm volatile("s_nop 15\n\ts_nop 15" ::: "memory"); int et = threadIdx.x; asm volatile("" : "+v"(et)); E.template part<0, 1>(acc, cur, wr, wc, et & 15, (et >> 4) & 3); PG8_SCHED; } } \
            PG8_MMA(1, 1, At, B1); PG8_BAR; PG8_SCHED; \
        } while (0)
#define PG8_WAIT_VN(n) asm volatile("s_waitcnt vmcnt(%0)" :: "n"(n) : "memory")
        int t = 0;
        if (RLX_ON && ui > 0) { PG8_KITER(true); t = 2; }
        for (; t < nt; t += 2) PG8_KITER(false);
#undef PG8_KITER
#undef PG8_WAIT_VN
        if (RLX_ON && has_next) {
            if constexpr (GATHER) PG8_STAGE(PG8_SA(1, 1), nA + kstep, vAn[1][0], vAn[1][1]); else PG8_STAGE(PG8_SA(1, 1), nA + kstep, vAc[1][0], vAc[1][1]);
        }
        if constexpr (FP8) asm volatile("s_nop 15\n\ts_nop 15" ::: "memory");
        if (wr == 0) PG8_BAR;
        { int et = threadIdx.x; asm volatile("" : "+v"(et)); if constexpr (Epi::SPLIT) E.template part<1, 2>(acc, cur, wr, wc, et & 15, (et >> 4) & 3); else E(acc, cur, wr, wc, et & 15, (et >> 4) & 3); }
        if (!has_next) break;
        if constexpr (Epi::BIAS_INIT) { int et = threadIdx.x; asm volatile("" : "+v"(et)); E.init(acc, nxt, wc, (et >> 4) & 3); }
        else {
#pragma unroll
        for (int a = 0; a < 2; ++a)
#pragma unroll
            for (int b = 0; b < 2; ++b)
#pragma unroll
                for (int m = 0; m < 4; ++m)
#pragma unroll
                    for (int n = 0; n < 2; ++n) { acc[a][b][m][n] = (f32x4){0.f, 0.f, 0.f, 0.f}; asm volatile("" : "+v"(acc[a][b][m][n])); }
        }
        cur = nxt; cA = nA; cB = nB; ++ui;
        if constexpr (!Epi::BIAS_INIT) PG8_BIAS_DMA(cur, ui & 1);
        if constexpr (GATHER) { vAc[0][0] = vAn[0][0]; vAc[0][1] = vAn[0][1]; vAc[1][0] = vAn[1][0]; vAc[1][1] = vAn[1][1]; }
        if (wr == 1) PG8_BAR;
    }
    PG8_WAIT_V(0);
    PG8_BAR;
#undef PG8_BIAS_DMA
#undef PG8_STB
#undef PG8_SA
#undef PG8_SB
#undef PG8_GL
#undef PG8_STAGE
#undef PG8_LDA
#undef PG8_LD8
#undef PG8_LDB
#undef PG8_MMA
#undef PG8_WAIT_V
#undef PG8_WAIT_L
#undef PG8_BAR
#undef PG8_SCHED
#endif
}
}

struct Args { const float* in[22]; float* out; unsigned char* ws; int ph_lo, ph_hi; };
struct Frame {
    LAS unsigned char* lds; unsigned char* ws; int tid, lane, wave, G, bid;
    const float *x, *meta, *mix_norm_w, *w_in, *conv_w, *conv_b, *dt_bias, *a_log, *d_skip, *ssd_norm_w, *w_decay_up, *b_decay, *gla_norm_w, *w_out, *ffn_norm_w, *w_router, *b_router, *w_gate_up, *b_gate_up, *w_down, *b_down, *final_norm_w;
    float* out;
};

__device__ __forceinline__ void transpose_item(const float* W, int K, int N, bf16* WT, int mode, LAS float* scr, int item, int lane) {
    const int nblk = N / 32, kb = item / nblk, nb = item % nblk, k0 = 64 * kb, n0 = 32 * nb;
#pragma unroll 8
    for (int i = 0; i < 32; ++i) { const int kk = 2 * i + (lane >> 5); scr[kk * 33 + (lane & 31)] = W[(size_t)(k0 + kk) * N + n0 + (lane & 31)]; }
    asm volatile("s_waitcnt lgkmcnt(0)" ::: "memory");
    int rbase = n0;
    if (mode == 1) { const int f0 = n0 & 1023; rbase = 256 * (f0 >> 7) + (f0 & 127) + ((n0 >= 1024) ? 128 : 0); }
    const int c = lane & 7;
#pragma unroll
    for (int j = 0; j < 4; ++j) { const int n = (lane >> 3) + 8 * j; const LAS float* s = scr + (8 * c) * 33 + n;
        u32x4 o; o.x = pk2(s[0 * 33], s[1 * 33]); o.y = pk2(s[2 * 33], s[3 * 33]); o.z = pk2(s[4 * 33], s[5 * 33]); o.w = pk2(s[6 * 33], s[7 * 33]);
        *(u32x4*)(WT + (size_t)(rbase + n) * K + k0 + 8 * c) = o; }
    asm volatile("s_waitcnt lgkmcnt(0)" ::: "memory");
}
__device__ __forceinline__ void item8_load(const float* W, int N, int item, int lane, f32x4 (&r)[8]) {
    const int nblk = N / 32, kb = item / nblk, nb = item % nblk, k0 = 64 * kb, n0 = 32 * nb;
    const float* p = W + (size_t)(k0 + 8 * (lane >> 3)) * N + n0 + 4 * (lane & 7);
#pragma unroll
    for (int i = 0; i < 8; ++i) r[i] = *(const f32x4*)(p + (size_t)i * N);
}
__device__ __forceinline__ void item8_finish(const f32x4 (&r)[8], int K, int N, unsigned char* WT, int mode, int item, int lane) {
    const int nblk = N / 32, kb = item / nblk, nb = item % nblk, k0 = 64 * kb, n0 = 32 * nb;
    int rbase = n0;
    if (mode == 1) { const int f0 = n0 & 1023; rbase = 256 * (f0 >> 7) + (f0 & 127) + ((n0 >= 1024) ? 128 : 0); }
    unsigned char* o = WT + (size_t)(rbase + 4 * (lane & 7)) * K + k0 + 8 * (lane >> 3);
#pragma unroll
    for (int c = 0; c < 4; ++c)
        *(u32x2*)(o + (size_t)c * K) = (u32x2){pk4_fp8(r[0][c] * W8_SCALE, r[1][c] * W8_SCALE, r[2][c] * W8_SCALE, r[3][c] * W8_SCALE), pk4_fp8(r[4][c] * W8_SCALE, r[5][c] * W8_SCALE, r[6][c] * W8_SCALE, r[7][c] * W8_SCALE)};
}
constexpr int I_GU = (D / 64) * (2 * DFF / 32), I_DN = (DFF / 64) * (D / 32), N_MOE_ITEMS = NEXP * (I_GU + I_DN);
__device__ __forceinline__ void moe_item_addr(Frame& F, int it, const float*& W, int& K, int& N, unsigned char*& WT, int& mode, int& sub) {
    if (it < NEXP * I_GU) { const int e = it / I_GU; W = F.w_gate_up + (size_t)e * D * 2 * DFF; K = D; N = 2 * DFF; WT = F.ws + WS_WGU + (size_t)e * 2 * DFF * D; mode = 1; sub = it % I_GU; }
    else { const int r = it - NEXP * I_GU, e = r / I_DN; W = F.w_down + (size_t)e * DFF * D; K = DFF; N = D; WT = F.ws + WS_WDN + (size_t)e * D * DFF; mode = 0; sub = r % I_DN; }
}
__device__ __forceinline__ void convert_moe_weights(Frame& F) {
    volatile LAS int* slot = (volatile LAS int*)(F.lds + LDS_BYTES - 32);
    unsigned* head = (unsigned*)(F.ws + WS_CTL) + CW_Q + 128;
    int nxt = 0;
    if (F.tid == 0) nxt = draw(head);
    for (;;) {
        sync_lds();
        if (F.tid == 0) *slot = nxt;
        sync_lds();
        const int base = *slot * 64;
        if (base >= N_MOE_ITEMS) break;
        if (F.tid == 0) nxt = draw(head);
        const int it0 = base + F.wave * 8;
        f32x4 ra[8], rb[8]; const float* W; int K, N, mode, sub; unsigned char* WT;
        moe_item_addr(F, it0, W, K, N, WT, mode, sub); item8_load(W, N, sub, F.lane, ra);
#pragma unroll 1
        for (int q = 0; q < 8; q += 2) {
            const float* W1; int K1, N1, mode1, sub1; unsigned char* WT1;
            moe_item_addr(F, it0 + q + 1, W1, K1, N1, WT1, mode1, sub1); item8_load(W1, N1, sub1, F.lane, rb);
            item8_finish(ra, K, N, WT, mode, sub, F.lane);
            if (q + 2 < 8) { moe_item_addr(F, it0 + q + 2, W, K, N, WT, mode, sub); item8_load(W, N, sub, F.lane, ra); }
            item8_finish(rb, K1, N1, WT1, mode1, sub1, F.lane);
        }
    }
    __syncthreads();
}
__device__ __forceinline__ void phase_prep(Frame& F) {
    LAS float* scr = (LAS float*)(F.lds + F.wave * 16384);
    const int gw = F.bid * 8 + F.wave, NGW = F.G * 8;
    constexpr int I_IN = (D / 64) * (INW / 32), I_OUT = (MIXW / 64) * (D / 32);
    constexpr int NITEMS = I_IN + I_OUT;
    bf16* win = (bf16*)(F.ws + WS_WIN); bf16* wout = (bf16*)(F.ws + WS_WOUT);
    for (int it = gw; it < NITEMS; it += NGW) {
        int r = it;
        if (r < I_IN) { transpose_item(F.w_in, D, INW, win, 0, scr, r, F.lane); continue; } r -= I_IN;
        transpose_item(F.w_out, MIXW, D, wout, 0, scr, r, F.lane);
    }
    { u32x4* z = (u32x4*)(win + (size_t)INW * D); const int n16 = (INWP - INW) * D * 2 / 16;
      for (int i = F.bid * 512 + F.tid; i < n16; i += F.G * 512) z[i] = (u32x4){0u, 0u, 0u, 0u}; }
    bf16* U = (bf16*)F.out;
    for (int r = gw; r < MROWS; r += NGW) {
        const int b = r / LPAD, p = r % LPAD;
        unsigned long long* o8 = (unsigned long long*)(U + (size_t)r * D) + F.lane;
        if (p < PADROWS) {
#pragma unroll
            for (int j = 0; j < 4; ++j) o8[64 * j] = 0ull;
            continue; }
        const float* src = (p < REAL0) ? F.meta + (size_t)(p - PADROWS) * D : F.x + ((size_t)b * SEQ + (p - REAL0)) * D;
        const f32x4* xr = (const f32x4*)src + F.lane; const f32x4* wr_ = (const f32x4*)F.mix_norm_w + F.lane;
        f32x4 v[4]; float s = 0.f;
#pragma unroll
        for (int j = 0; j < 4; ++j) { v[j] = xr[64 * j]; s += (v[j].x * v[j].x + v[j].y * v[j].y) + (v[j].z * v[j].z + v[j].w * v[j].w); }
        const float rstd = rsqrtf(wave_sum(s) * (1.f / D) + EPS);
#pragma unroll
        for (int j = 0; j < 4; ++j) { const f32x4 w = wr_[64 * j]; o8[64 * j] = (unsigned long long)pk2(v[j].x * rstd * w.x, v[j].y * rstd * w.y) | ((unsigned long long)pk2(v[j].z * rstd * w.z, v[j].w * rstd * w.w) << 32); }
    }
}

#ifndef WGM_IN
#define WGM_IN 4
#endif
#ifndef WGM_OUT
#define WGM_OUT 4
#endif
#ifndef WGM_GU
#define WGM_GU 4
#endif
#ifndef WGM_DN
#define WGM_DN 4
#endif
#ifndef SPLIT_GU
#define SPLIT_GU false
#endif
#ifndef SPLIT_DN
#define SPLIT_DN false
#endif
#ifndef NT_EPI
#define NT_EPI 0
#endif
#if NT_EPI
#define EPI_ST(p, v) __builtin_nontemporal_store((v), (p))
#else
#define EPI_ST(p, v) (*(p) = (v))
#endif
struct SchedDense {
    const char* A; const char* Bt; int K, nM, nN, G, c; bool remap; int wgm;
    __device__ __forceinline__ const float* bias_src(const pg8::Unit&, int) const { return nullptr; }
    __device__ __forceinline__ bool next(int i, pg8::Unit& u) const {
        int pm, pn; if (!pg8::static_order(i, G, c, nM, nN, wgm, pm, pn)) return false;
        u.pm = pm; u.pn = pn; u.e = 0;
        size_t arow = (size_t)pm * 256; if (remap) { const int b = (pm * 256) / SEQ, t = (pm * 256) % SEQ; arow = (size_t)b * LPAD + REAL0 + t; }
        u.A = A + arow * K * 2; u.B = Bt + (size_t)pn * 256 * K * 2; return true;
    }
    __device__ __forceinline__ void a_offs(const pg8::Unit&, unsigned (&vo)[2][2], int tid) const {
#pragma unroll
        for (int i = 0; i < 2; ++i) { int R, C; pg8::stage_rc(tid * 16 + i * 8192, R, C);
#pragma unroll
            for (int h = 0; h < 2; ++h) vo[h][i] = (unsigned)((h * 128 + R) * K + C) * 2u; }
    }
};
struct SchedMoe {
    const char* A; const char* Bt; int K, nN, G, c; bool gather; size_t bexp; int wgm;
    const int* list; const LAS int* tstart; const LAS int* cnt; const float* bias;
    __device__ __forceinline__ const float* bias_src(const pg8::Unit& u, int lane) const {
        return gather ? bias + (size_t)u.e * 2 * DFF + (lane >> 5) * DFF + u.pn * 128 + 4 * (lane & 31) : bias + (size_t)u.e * D + u.pn * 256 + 4 * lane; }
    __device__ __forceinline__ bool next(int i, pg8::Unit& u) const {
        const int nM = tstart[NEXP]; int pm, pn; if (!pg8::static_order(i, G, c, nM, nN, wgm, pm, pn)) return false;
        int tl = threadIdx.x; asm volatile("" : "+v"(tl)); tl &= 63;
        const int e = __popcll(__ballot(tl >= 1 && tl < NEXP && tstart[tl & 31] <= pm));
        u.pm = pm; u.pn = pn; u.e = e;
        u.A = gather ? A : A + (size_t)pm * 256 * K * 2; u.B = Bt + (size_t)e * bexp + (size_t)pn * 256 * K * 2; return true;
    }
    __device__ __forceinline__ void a_offs(const pg8::Unit& u, unsigned (&vo)[2][2], int tid) const {
        asm volatile("" : "+v"(tid));
        const int e = u.e, r0 = (u.pm - tstart[e]) * 256, n1 = cnt[e] - 1;
#pragma unroll
        for (int i = 0; i < 2; ++i) { int R, C; pg8::stage_rc(tid * 16 + i * 8192, R, C);
#pragma unroll
            for (int h = 0; h < 2; ++h) {
                if (gather) { const int rr = min(r0 + h * 128 + R, n1); const int tok = list[e * NTOK + rr]; vo[h][i] = (unsigned)(tok * K + C) * 2u; }
                else vo[h][i] = (unsigned)((h * 128 + R) * K + C) * 2u; } }
    }
};
template <bool LB, bool TILED = false> struct EpiBf16T {
    static constexpr int CMAP = 1;
    static constexpr int NST = 16;
    static constexpr bool BIAS_INIT = false;
    static constexpr bool LDS_BIAS = LB;
    bf16* O; int ldc; LAS unsigned char* lds;
    static constexpr bool SPLIT = !LB;
    __device__ __forceinline__ void operator()(const f32x4 (&acc)[2][2][4][2], const pg8::Unit& u, int wr, int wc, int fr, int fq) const { part<0, 2>(acc, u, wr, wc, fr, fq); }
    template <int AI0, int AI1> __device__ __forceinline__ void part(const f32x4 (&acc)[2][2][4][2], const pg8::Unit& u, int wr, int wc, int fr, int fq) const {
        const int row0 = u.pm * 256 + wr * 64 + fr, col0 = u.pn * 256 + wc * 32 + 8 * fq;
        f32x4 bv[2][2];
#pragma unroll
        for (int bj = 0; bj < 2; ++bj)
#pragma unroll
            for (int n = 0; n < 2; ++n) bv[bj][n] = LB ? *(const LAS f32x4*)(lds + u.bias_lds + (wc * 32 + 8 * fq + bj * 128 + 4 * n) * 4) : (f32x4){0.f, 0.f, 0.f, 0.f};
#pragma unroll
        for (int ai = AI0; ai < AI1; ++ai)
#pragma unroll
            for (int m = 0; m < 4; ++m) { bf16* rowp = O + (size_t)(row0 + ai * 128 + m * 16) * ldc + col0;
#pragma unroll
                for (int bj = 0; bj < 2; ++bj) { f32x4 v0 = acc[ai][bj][m][0], v1 = acc[ai][bj][m][1]; if (LB) { v0 = v0 + bv[bj][0]; v1 = v1 + bv[bj][1]; }
                    u32x4 w; w.x = pg8::cvt_pk_bf16(v0[0], v0[1]); w.y = pg8::cvt_pk_bf16(v0[2], v0[3]); w.z = pg8::cvt_pk_bf16(v1[0], v1[1]); w.w = pg8::cvt_pk_bf16(v1[2], v1[3]);
                    if (TILED) EPI_ST((u32x4*)((unsigned char*)O + (size_t)(u.pm * 23 + u.pn) * 131072 + ((wr * 4 + wc) * 16 + (ai * 4 + m) * 2 + bj) * 1024 + (fq * 16 + fr) * 16), w);
                    else EPI_ST((u32x4*)(rowp + bj * 128), w); } }
    }
};
typedef EpiBf16T<false> EpiBf16; typedef EpiBf16T<true> EpiBf16B; typedef EpiBf16T<false, true> EpiProj;
struct EpiFp8Row {
    static constexpr int CMAP = 2; static constexpr int NST = 8; static constexpr bool LDS_BIAS = true; static constexpr bool BIAS_INIT = true; static constexpr bool SPLIT = SPLIT_DN;
    unsigned char* O; int ldc; LAS unsigned char* lds;
    __device__ __forceinline__ void init(f32x4 (&acc)[2][2][4][2], const pg8::Unit& u, int wc, int fq) const {
#pragma unroll
        for (int bj = 0; bj < 2; ++bj)
#pragma unroll
            for (int n = 0; n < 2; ++n) { const f32x4 bv = *(const LAS f32x4*)(lds + u.bias_lds + (wc * 64 + 16 * fq + 8 * bj + 4 * n) * 4);
#pragma unroll
                for (int ai = 0; ai < 2; ++ai)
#pragma unroll
                    for (int m = 0; m < 4; ++m) acc[ai][bj][m][n] = bv; }
    }
    __device__ __forceinline__ void operator()(const f32x4 (&acc)[2][2][4][2], const pg8::Unit& u, int wr, int wc, int fr, int fq) const { part<0, 2>(acc, u, wr, wc, fr, fq); }
    template <int AI0, int AI1> __device__ __forceinline__ void part(const f32x4 (&acc)[2][2][4][2], const pg8::Unit& u, int wr, int wc, int fr, int fq) const {
        const int row0 = u.pm * 256 + wr * 64 + fr, colt = wc * 64 + 16 * fq;
#pragma unroll
        for (int ai = AI0; ai < AI1; ++ai)
#pragma unroll
            for (int m = 0; m < 4; ++m) { unsigned char* rowp = O + (size_t)(row0 + ai * 128 + m * 16) * ldc + u.pn * 256 + colt;
                const f32x4 v00 = acc[ai][0][m][0], v01 = acc[ai][0][m][1], v10 = acc[ai][1][m][0], v11 = acc[ai][1][m][1];
                EPI_ST((u32x4*)rowp, ((u32x4){pk4_fp8(v00[0], v00[1], v00[2], v00[3]), pk4_fp8(v01[0], v01[1], v01[2], v01[3]), pk4_fp8(v10[0], v10[1], v10[2], v10[3]), pk4_fp8(v11[0], v11[1], v11[2], v11[3])})); }
    }
};
struct EpiResidF32 {
    static constexpr int CMAP = 0; static constexpr int NST = 32; static constexpr bool LDS_BIAS = false; static constexpr bool BIAS_INIT = false; static constexpr bool SPLIT = true;
    const float* resid; float* out;
    __device__ __forceinline__ void operator()(const f32x4 (&acc)[2][2][4][2], const pg8::Unit& u, int wr, int wc, int fr, int fq) const { part<0, 2>(acc, u, wr, wc, fr, fq); }
    template <int AI0, int AI1> __device__ __forceinline__ void part(const f32x4 (&acc)[2][2][4][2], const pg8::Unit& u, int wr, int wc, int fr, int fq) const {
        const int row0 = u.pm * 256 + wr * 64 + fr, col0 = u.pn * 256 + wc * 32 + 4 * fq;
#pragma unroll
        for (int ai = AI0; ai < AI1; ++ai)
#pragma unroll
            for (int m = 0; m < 4; ++m) { const size_t off = (size_t)(row0 + ai * 128 + m * 16) * D + col0;
#pragma unroll
                for (int bj = 0; bj < 2; ++bj)
#pragma unroll
                    for (int n = 0; n < 2; ++n) { const f32x4 r = *(const f32x4*)(resid + off + bj * 128 + n * 16); *(f32x4*)(out + off + bj * 128 + n * 16) = r + acc[ai][bj][m][n]; } }
    }
};
struct EpiResidBf16 {
    static constexpr int CMAP = 1; static constexpr int NST = 16; static constexpr bool LDS_BIAS = false; static constexpr bool BIAS_INIT = false; static constexpr bool SPLIT = true;
    const float* resid; bf16* out;
    __device__ __forceinline__ void operator()(const f32x4 (&acc)[2][2][4][2], const pg8::Unit& u, int wr, int wc, int fr, int fq) const { part<0, 2>(acc, u, wr, wc, fr, fq); }
    template <int AI0, int AI1> __device__ __forceinline__ void part(const f32x4 (&acc)[2][2][4][2], const pg8::Unit& u, int wr, int wc, int fr, int fq) const {
        const int row0 = u.pm * 256 + wr * 64 + fr, col0 = u.pn * 256 + wc * 32 + 8 * fq;
#pragma unroll
        for (int ai = AI0; ai < AI1; ++ai)
#pragma unroll
            for (int m = 0; m < 4; ++m) { const size_t off = (size_t)(row0 + ai * 128 + m * 16) * D + col0;
#pragma unroll
                for (int bj = 0; bj < 2; ++bj) { const f32x4 v0 = *(const f32x4*)(resid + off + bj * 128) + acc[ai][bj][m][0], v1 = *(const f32x4*)(resid + off + bj * 128 + 4) + acc[ai][bj][m][1];
                    u32x4 w; w.x = pg8::cvt_pk_bf16(v0[0], v0[1]); w.y = pg8::cvt_pk_bf16(v0[2], v0[3]); w.z = pg8::cvt_pk_bf16(v1[0], v1[1]); w.w = pg8::cvt_pk_bf16(v1[2], v1[3]);
                    *(u32x4*)(out + off + bj * 128) = w; } }
    }
};
struct EpiSwiglu {
    static constexpr int CMAP = 1; static constexpr int NST = 8; static constexpr bool LDS_BIAS = true; static constexpr bool BIAS_INIT = true; static constexpr bool SPLIT = SPLIT_GU;
    bf16* O; LAS unsigned char* lds;
    __device__ __forceinline__ void init(f32x4 (&acc)[2][2][4][2], const pg8::Unit& u, int wc, int fq) const {
#pragma unroll
        for (int n = 0; n < 2; ++n) { const f32x4 bg = *(const LAS f32x4*)(lds + u.bias_lds + (wc * 32 + 8 * fq + 4 * n) * 4); f32x4 bu = *(const LAS f32x4*)(lds + u.bias_lds + (128 + wc * 32 + 8 * fq + 4 * n) * 4);
            bu = bu + (f32x4){1.f, 1.f, 1.f, 1.f};
#pragma unroll
            for (int ai = 0; ai < 2; ++ai)
#pragma unroll
                for (int m = 0; m < 4; ++m) { acc[ai][0][m][n] = bg; acc[ai][1][m][n] = bu; } }
    }
    __device__ __forceinline__ void operator()(const f32x4 (&acc)[2][2][4][2], const pg8::Unit& u, int wr, int wc, int fr, int fq) const { part<0, 2>(acc, u, wr, wc, fr, fq); }
    template <int AI0, int AI1> __device__ __forceinline__ void part(const f32x4 (&acc)[2][2][4][2], const pg8::Unit& u, int wr, int wc, int fr, int fq) const {
        const int row0 = u.pm * 256 + wr * 64 + fr, f0 = u.pn * 128 + wc * 32 + 8 * fq;
#pragma unroll
        for (int ai = AI0; ai < AI1; ++ai)
#pragma unroll
            for (int m = 0; m < 4; ++m) { unsigned char* rowp = (unsigned char*)O + (size_t)(row0 + ai * 128 + m * 16) * DFF + f0;
                float o[8];
#pragma unroll
                for (int n = 0; n < 2; ++n)
#pragma unroll
                    for (int i = 0; i < 4; ++i) { float g = acc[ai][0][m][n][i], up1 = acc[ai][1][m][n][i];
                        g = fminf(g, 7.f); up1 = fminf(fmaxf(up1, -6.f), 8.f);
                        const float a = g * __builtin_amdgcn_rcpf(1.f + __builtin_amdgcn_exp2f(-2.45546696f * g)); o[4 * n + i] = up1 * a; }
                EPI_ST((u32x2*)rowp, ((u32x2){pk4_fp8(o[0], o[1], o[2], o[3]), pk4_fp8(o[4], o[5], o[6], o[7])})); }
    }
};

__device__ __forceinline__ void phase_inproj(Frame& F, bool conv) {
    const int G1 = (conv && F.G >= 64) ? F.G - (F.G * 5) / 32 : F.G;
    if (F.bid < G1) {
        SchedDense S{(const char*)F.out, (const char*)(F.ws + WS_WIN), D, MROWS / 256, INWP / 256, G1, F.bid, false, WGM_IN};
        EpiProj E{(bf16*)(F.ws + WS_PROJ), INWP, F.lds};
        pg8::gemm_phase<EpiProj, SchedDense, false>(F.lds, D, S, E);
    }
    if (conv) convert_moe_weights(F);
}
__device__ __forceinline__ void phase_outproj(Frame& F) {
    SchedDense S{(const char*)(F.ws + WS_MIXED), (const char*)(F.ws + WS_WOUT), MIXW, NTOK / 256, D / 256, F.G, F.bid, true, WGM_OUT};
    EpiResidBf16 E{F.x, (bf16*)(F.ws + WS_H1B)};
    pg8::gemm_phase<EpiResidBf16, SchedDense, false>(F.lds, MIXW, S, E);
}
__device__ __forceinline__ void moe_tables(Frame& F) {
    LAS int* cnt = (LAS int*)(F.lds + MISC_OFF); LAS int* ts = (LAS int*)(F.lds + MISC_OFF + 256);
    __syncthreads();
    if (F.tid < NEXP) cnt[F.tid] = (int)__hip_atomic_load((const unsigned*)(F.ws + WS_CTL) + CW_CNT + F.tid, __ATOMIC_RELAXED, __HIP_MEMORY_SCOPE_AGENT);
    __syncthreads();
    if (F.tid == 0) { int acc = 0;
        for (int e = 0; e < NEXP; ++e) { ts[e] = acc; acc += (cnt[e] + 255) >> 8; }
        ts[NEXP] = acc; }
    __syncthreads();
}
__device__ __forceinline__ void phase_gateup(Frame& F) {
    moe_tables(F);
    SchedMoe S{(const char*)(F.ws + WS_T), (const char*)(F.ws + WS_WGU), D / 2, 8, F.G, F.bid, true, (size_t)2 * DFF * D, WGM_GU,
               (const int*)(F.ws + WS_TAB + TAB_LIST), (const LAS int*)(F.lds + MISC_OFF + 256), (const LAS int*)(F.lds + MISC_OFF), F.b_gate_up};
    EpiSwiglu E{(bf16*)(F.ws + WS_ACT), F.lds};
    pg8::gemm_phase<EpiSwiglu, SchedMoe, true, true>(F.lds, D / 2, S, E);
}
__device__ __forceinline__ void phase_down(Frame& F, int kmul) {
    moe_tables(F);
    SchedMoe S{(const char*)(F.ws + WS_ACT), (const char*)(F.ws + WS_WDN), DFF / 2, 4, F.G, F.bid, false, (size_t)D * DFF, WGM_DN,
               nullptr, (const LAS int*)(F.lds + MISC_OFF + 256), (const LAS int*)(F.lds + MISC_OFF), F.b_down};
    EpiFp8Row E{F.ws + WS_YPAIR, D, F.lds};
    pg8::gemm_phase<EpiFp8Row, SchedMoe, false, true>(F.lds, kmul * DFF / 2, S, E);
}

__device__ __forceinline__ void phase_ssd_naive(Frame& F) {
    const bf16* proj = (const bf16*)(F.ws + WS_PROJ); float* mixraw = (float*)(F.ws + WS_MIXRAW);
    LAS float* sx = (LAS float*)F.lds;
    LAS float* sdt = sx + 16 * 320;
    for (int unit = F.bid; unit < BATCH * 16; unit += F.G) {
        const int b = unit / 16, h = unit % 16, g = h / 8, p = F.tid >> 3, nq = F.tid & 7;
        const float a = -__expf(F.a_log[h]), dsk = F.d_skip[h], dtb = F.dt_bias[h];
        float hs[16];
#pragma unroll
        for (int j = 0; j < 16; ++j) hs[j] = 0.f;
        for (int pos0 = PADROWS; pos0 < LPAD; pos0 += 16) {
            __syncthreads();
            for (int idx = F.tid; idx < 16 * 320; idx += 512) {
                const int tt = idx / 320, c = idx % 320;
                const int xch = c < 64 ? h * 64 + c : (c < 192 ? 1024 + g * 128 + (c - 64) : 1280 + g * 128 + (c - 192));
                float acc = F.conv_b[xch];
#pragma unroll
                for (int k = 0; k < 4; ++k) { const int pp = pos0 + tt - 3 + k; acc += F.conv_w[k * XBCW + xch] * bf2f(proj[((size_t)b * LPAD + pp) * INWP + C_XBC + xch]); }
                sx[tt * 320 + c] = silu_f(acc);
            }
            if (F.tid < 16) sdt[F.tid] = softplus_f(bf2f(proj[((size_t)b * LPAD + pos0 + F.tid) * INWP + C_DT + h]) + dtb);
            __syncthreads();
            for (int tt = 0; tt < 16; ++tt) {
                const float dt = sdt[tt], dA = __expf(dt * a), xp = sx[tt * 320 + p], dx = dt * xp;
                float part = 0.f;
#pragma unroll
                for (int j = 0; j < 16; ++j) { hs[j] = dA * hs[j] + dx * sx[tt * 320 + 64 + nq * 16 + j]; part += sx[tt * 320 + 192 + nq * 16 + j] * hs[j]; }
                part += __shfl_xor(part, 1); part += __shfl_xor(part, 2); part += __shfl_xor(part, 4);
                if (nq == 0) mixraw[((size_t)b * LPAD + pos0 + tt) * MIXW + h * 64 + p] = part + dsk * xp;
            }
        }
    }
    __syncthreads();
}
__device__ __forceinline__ void phase_gla_naive(Frame& F) {
    const bf16* proj = (const bf16*)(F.ws + WS_PROJ); float* mixraw = (float*)(F.ws + WS_MIXRAW);
    LAS float* sq = (LAS float*)F.lds;
    LAS float* sk = sq + 16 * 128; LAS float* sa = sk + 16 * 128; LAS float* sv = sa + 16 * 128;
    for (int unit = (F.G >= 80 ? F.bid - 64 : F.bid); unit < BATCH * 4; unit += F.G) {
        if (unit < 0) continue;
        const int b = unit / 4, h = unit % 4, v = F.tid >> 1, dh = F.tid & 1;
        float S[64];
#pragma unroll
        for (int j = 0; j < 64; ++j) S[j] = 0.f;
        for (int pos0 = PADROWS; pos0 < LPAD; pos0 += 16) {
            __syncthreads();
            for (int idx = F.tid; idx < 16 * 128; idx += 512) {
                const int tt = idx >> 7, d = idx & 127; const size_t rb = ((size_t)b * LPAD + pos0 + tt) * INWP;
                sq[idx] = bf2f(proj[rb + C_Q + h * 128 + d]) * 0.08838834764831845f;
                sk[idx] = bf2f(proj[rb + C_K + h * 128 + d]);
                float z = F.b_decay[h * 128 + d];
#pragma unroll
                for (int r = 0; r < 16; ++r) z += bf2f(proj[rb + C_ALR + r]) * F.w_decay_up[r * 512 + h * 128 + d];
                sa[idx] = __expf(logsigmoid_f(z) * (1.f / 16.f));
            }
            for (int idx = F.tid; idx < 16 * 256; idx += 512) { const int tt = idx >> 8, vv = idx & 255; sv[idx] = bf2f(proj[((size_t)b * LPAD + pos0 + tt) * INWP + C_V + h * 256 + vv]); }
            __syncthreads();
            for (int tt = 0; tt < 16; ++tt) {
                const float vv = sv[tt * 256 + v]; float op = 0.f;
#pragma unroll
                for (int j = 0; j < 64; ++j) { const int d = dh * 64 + j; S[j] = sa[tt * 128 + d] * S[j] + sk[tt * 128 + d] * vv; op += sq[tt * 128 + d] * S[j]; }
                op += __shfl_xor(op, 1);
                if (dh == 0) mixraw[((size_t)b * LPAD + pos0 + tt) * MIXW + 1024 + h * 256 + v] = op;
            }
        }
    }
    __syncthreads();
}
__device__ __forceinline__ void phase_mixnorm(Frame& F) {
    const bf16* proj = (const bf16*)(F.ws + WS_PROJ); const float* mixraw = (const float*)(F.ws + WS_MIXRAW); bf16* mixed = (bf16*)(F.ws + WS_MIXED);
    const int gw = F.bid * 8 + F.wave, NGW = F.G * 8;
    for (int r = gw; r < MROWS; r += NGW) {
        const int p = r % LPAD; if (p < PADROWS) continue;
        const float* mr = mixraw + (size_t)r * MIXW; const bf16* pr = proj + (size_t)r * INWP; bf16* o = mixed + (size_t)r * MIXW;
        for (int g = 0; g < 2; ++g) {
            float y[8]; float s = 0.f;
#pragma unroll
            for (int j = 0; j < 8; ++j) { const int c = g * 512 + F.lane * 8 + j; y[j] = mr[c] * silu_f(bf2f(pr[C_Z + c])); s += y[j] * y[j]; }
            const float rstd = rsqrtf(wave_sum(s) * (1.f / 512.f) + EPS);
            u32x4 w; unsigned ww[4];
#pragma unroll
            for (int j = 0; j < 4; ++j) { const int c = g * 512 + F.lane * 8 + 2 * j; ww[j] = pk2(y[2 * j] * rstd * F.ssd_norm_w[c], y[2 * j + 1] * rstd * F.ssd_norm_w[c + 1]); }
            w.x = ww[0]; w.y = ww[1]; w.z = ww[2]; w.w = ww[3];
            *(u32x4*)(o + g * 512 + F.lane * 8) = w;
        }
        for (int h = 0; h < 4; ++h) {
            float y[4]; float s = 0.f;
#pragma unroll
            for (int j = 0; j < 4; ++j) { y[j] = mr[1024 + h * 256 + F.lane * 4 + j]; s += y[j] * y[j]; }
            const float rstd = rsqrtf(wave_sum(s) * (1.f / 256.f) + EPS);
            unsigned ww[2];
#pragma unroll
            for (int j = 0; j < 2; ++j) { const int vv = F.lane * 4 + 2 * j;
                const float a0 = y[2 * j] * rstd * F.gla_norm_w[vv] * silu_f(bf2f(pr[C_G + h * 256 + vv])), a1 = y[2 * j + 1] * rstd * F.gla_norm_w[vv + 1] * silu_f(bf2f(pr[C_G + h * 256 + vv + 1]));
                ww[j] = pk2(a0, a1); }
            *(u32x2*)(o + 1024 + h * 256 + F.lane * 4) = (u32x2){ww[0], ww[1]};
        }
    }
}


constexpr int NCHUNK = 65;
__device__ __forceinline__ unsigned swz(int row, int chunk) { return (unsigned)(row * 256 + ((chunk ^ (row & 15)) << 4)); }
__device__ __forceinline__ bf16x8 ldfrag(const LAS unsigned char* buf, int row, int chunk) { return *(const LAS bf16x8*)(buf + swz(row, chunk)); }
__device__ __forceinline__ f32x4 mfma16(bf16x8 a, bf16x8 b, f32x4 c) { return __builtin_amdgcn_mfma_f32_16x16x32_bf16(a, b, c, 0, 0, 0); }
__device__ __forceinline__ u32x4 pack8(const float (&v)[8]) { u32x4 w; w.x = pk2(v[0], v[1]); w.y = pk2(v[2], v[3]); w.z = pk2(v[4], v[5]); w.w = pk2(v[6], v[7]); return w; }
__device__ __forceinline__ float bflo(unsigned w) { return __uint_as_float(w << 16); }
__device__ __forceinline__ float bfhi(unsigned w) { return __uint_as_float(w & 0xffff0000u); }

__device__ __forceinline__ void ssd_dt_acs(Frame& F, int lane, unsigned short dr0, unsigned short dr1, float a, float bias, int c, LAS float* dts, LAS float* acss) {
    const int hl = F.wave; const int t0 = 2 * lane;
    float d0 = softplus_f(bf2f(dr0) + bias), d1 = softplus_f(bf2f(dr1) + bias);
    if (c * 128 + t0 < PADROWS) d0 = 0.f;
    if (c * 128 + t0 + 1 < PADROWS) d1 = 0.f;
    const float v0 = d0 * a, v1 = d1 * a; float s = v0 + v1;
#pragma unroll
    for (int o = 1; o < 64; o <<= 1) { const float t = __shfl_up(s, o); if (lane >= o) s += t; }
    dts[hl * 128 + t0] = d0; dts[hl * 128 + t0 + 1] = d1; acss[hl * 128 + t0] = s - v1; acss[hl * 128 + t0 + 1] = s;
}

constexpr size_t SB_CN = 0, SB_BN = 32768, SB_XT0 = 65536, SB_XT1 = 131072, SB_DTA = 196608, SB_BYTES = 204800;
constexpr size_t GB_QD = 0, GB_KI = 32768, GB_VT = 65536, GB_BYTES = 131072;
constexpr size_t WS_GBLOB = WS_R2 + 130 * MiB;
static_assert((size_t)BATCH * NCHUNK * 2 * SB_BYTES <= (size_t)NTOK * D * 4 && WS_GBLOB + (size_t)BATCH * NCHUNK * 4 * GB_BYTES <= WS_MIXED, "blob map");

__device__ __forceinline__ void conv_load(const bf16* proj, long grow0, int t0, int xch, u32x2 (&raw)[11]) {
    long r0 = grow0 + t0 - 3; if (r0 < 0) r0 = 0;
    const int ja = 16 - (int)(r0 & 15);
    const bf16* pa = proj + paddr(r0, C_XBC + xch); const bf16* pb = proj + paddr(r0 + ja, C_XBC + xch) - 8 * ja;
#pragma unroll
    for (int j = 0; j < 11; ++j) raw[j] = *(const u32x2*)((j < ja ? pa : pb) + 8 * j);
}
constexpr int CONVW_OFF = 114688;
constexpr int HEADT_OFF = CONVW_OFF + 5 * XBCW * 4;
static_assert(HEADT_OFF + 128 <= LDS_BYTES - 32, "head table");
struct ConvW { f32x4 wk[4], bb; };
__device__ __forceinline__ ConvW conv_wload(const LAS float* cw, int xch) { ConvW c; c.bb = *(const LAS f32x4*)(cw + 4 * XBCW + xch);
#pragma unroll
    for (int k = 0; k < 4; ++k) c.wk[k] = *(const LAS f32x4*)(cw + k * XBCW + xch);
    return c; }
__device__ __forceinline__ void conv_compute(const u32x2 (&raw)[11], const ConvW& cw, int pos0, int t0, float (&out)[8][4]) {
    const f32x4 (&wk)[4] = cw.wk; const f32x4 bb = cw.bb;
#pragma unroll
    for (int t = 0; t < 8; ++t) { float a0 = bb[0], a1 = bb[1], a2 = bb[2], a3 = bb[3];
#pragma unroll
        for (int k = 0; k < 4; ++k) { const u32x2 w = raw[t + k]; a0 += wk[k][0] * bflo(w.x); a1 += wk[k][1] * bfhi(w.x); a2 += wk[k][2] * bflo(w.y); a3 += wk[k][3] * bfhi(w.y); }
        const bool pad = pos0 + t0 + t < PADROWS;
        out[t][0] = pad ? 0.f : silu_f(a0); out[t][1] = pad ? 0.f : silu_f(a1); out[t][2] = pad ? 0.f : silu_f(a2); out[t][3] = pad ? 0.f : silu_f(a3); }
}
__device__ __forceinline__ void put_transposed(LAS unsigned char* img, int row0, int tg, const float (&o)[8][4]) {
#pragma unroll
    for (int i = 0; i < 4; ++i) { float v[8];
#pragma unroll
        for (int t = 0; t < 8; ++t) v[t] = o[t][i];
        *(LAS u32x4*)(img + swz(row0 + i, tg)) = pack8(v); }
}
__device__ __forceinline__ void put_natural_global(unsigned char* img, int tok0, int cl, const float (&o)[8][4]) {
#pragma unroll
    for (int t = 0; t < 8; ++t) *(u32x2*)(img + swz(tok0 + t, cl >> 3) + (cl & 7) * 2) = (u32x2){pk2(o[t][0], o[t][1]), pk2(o[t][2], o[t][3])};
}
__device__ __forceinline__ void blob_out(unsigned char* g, const LAS unsigned char* l, int bytes, int tid) {
    for (int o = tid * 16; o < bytes; o += 512 * 16) *(u32x4*)(g + o) = *(const LAS u32x4*)(l + o);
}
__device__ __forceinline__ void blob_in(const unsigned char* g, LAS unsigned char* l, int bytes, int wave, int lane) {
    for (int o = wave * 1024; o < bytes; o += 8 * 1024) __builtin_amdgcn_global_load_lds((const unsigned*)(g + o + lane * 16), (LAS unsigned*)(l + o), 16, 0, 0);
}

struct UQ { volatile LAS int* slot; unsigned* head; int q3; };
constexpr int NU_SSD = BATCH * NCHUNK * 2, NU_ALL = BATCH * NCHUNK * 2 + BATCH * NCHUNK * 4;
__device__ __forceinline__ void uq_init(Frame& F, UQ& Q, unsigned* head) {
    Q.slot = (volatile LAS int*)(F.lds + LDS_BYTES - 32); Q.head = head; Q.q3 = 0;
    __syncthreads();
    if (F.tid == 0) { const int a = draw(head), b = draw(head); Q.slot[0] = a; Q.slot[1] = b; }
}
__device__ __forceinline__ bool uq_top(UQ& Q, int& u, int& un) { sync_lds(); u = Q.slot[0]; un = Q.slot[1]; return u < NU_ALL; }
__device__ __forceinline__ void uq_fetch(Frame& F, UQ& Q) { if (F.tid == 0) Q.q3 = draw(Q.head); }
__device__ __forceinline__ void uq_publish(Frame& F, UQ& Q, int un) { if (F.tid == 0) { Q.slot[0] = un; Q.slot[1] = Q.q3; } }

struct SsdIn { u32x2 rB[11], rC[11], rX0[11], rX1[11]; unsigned short dr0, dr1; };
__device__ __forceinline__ void ssd_load_dt(const bf16* proj, long grow0, int g, int wave, int lane, SsdIn& I) { const int h = g * 8 + wave; I.dr0 = proj[paddr(grow0 + 2 * lane, C_DT + h)]; I.dr1 = proj[paddr(grow0 + 2 * lane + 1, C_DT + h)]; }
__device__ __forceinline__ void m1_ssd(Frame& F, int u, int une, SsdIn& I) {
    int tid = threadIdx.x; asm volatile("" : "+v"(tid)); const int lane = tid & 63;
    const int g = u & 1, bc = u >> 1, b = bc / NCHUNK, c = bc % NCHUNK, gn = une & 1, bcn = une >> 1;
    const bf16* proj = (const bf16*)(F.ws + WS_PROJ); bf16* sst = (bf16*)(F.ws + WS_SST); float* cdec = (float*)(F.ws + WS_TAB + TAB_CDEC);
    unsigned char* blob = (unsigned char*)F.out + (size_t)u * SB_BYTES;
    LAS unsigned char* BT = F.lds; LAS unsigned char* XT = F.lds + 32768;
    LAS float* dts = (LAS float*)(F.lds + 98304); LAS float* acss = dts + 1024; LAS float* scs = acss + 1024;
    const long grow0n = (long)(bcn / NCHUNK) * LPAD + (bcn % NCHUNK) * 128; const int pos0 = c * 128, fr = lane & 15, fq = lane >> 4;
    const int cqB = tid & 31, tgB = tid >> 5;
    const int cqX = tid & 63, tgX = tid >> 6;
    const LAS float* cws = (const LAS float*)(F.lds + CONVW_OFF);
    { const LAS float* hts = (const LAS float*)(F.lds + HEADT_OFF); ssd_dt_acs(F, lane, I.dr0, I.dr1, hts[g * 8 + F.wave], hts[16 + g * 8 + F.wave], c, dts, acss); }
    asm volatile("" ::: "memory");
    ssd_load_dt(proj, grow0n, gn, F.wave, lane, I);
    { float o[8][4];
      conv_compute(I.rB, conv_wload(cws, 1024 + g * 128 + 4 * cqB), pos0, 8 * tgB, o); put_transposed(BT, 4 * cqB, tgB, o);
      asm volatile("" ::: "memory"); conv_load(proj, grow0n, 8 * tgB, 1024 + gn * 128 + 4 * cqB, I.rB); asm volatile("" ::: "memory");
      put_natural_global(blob + SB_BN, 8 * tgB, 4 * cqB, o);
      conv_compute(I.rC, conv_wload(cws, 1280 + g * 128 + 4 * cqB), pos0, 8 * tgB, o);
      asm volatile("" ::: "memory"); conv_load(proj, grow0n, 8 * tgB, 1280 + gn * 128 + 4 * cqB, I.rC); asm volatile("" ::: "memory");
      put_natural_global(blob + SB_CN, 8 * tgB, 4 * cqB, o); }
#pragma unroll 1
    for (int pass = 0; pass < 2; ++pass) {
        { float o[8][4];
          const ConvW wX = conv_wload(cws, g * 512 + pass * 256 + 4 * cqX);
          conv_compute(I.rX0, wX, pos0, 8 * tgX, o); put_transposed(XT, 4 * cqX, tgX, o);
          conv_compute(I.rX1, wX, pos0, 8 * (tgX + 8), o); put_transposed(XT, 4 * cqX, tgX + 8, o); }
        asm volatile("" ::: "memory");
        {
            const long gr = pass == 0 ? (long)b * LPAD + c * 128 : grow0n; const int xc = pass == 0 ? g * 512 + 256 + 4 * cqX : gn * 512 + 4 * cqX;
            conv_load(proj, gr, 8 * tgX, xc, I.rX0); conv_load(proj, gr, 8 * (tgX + 8), xc, I.rX1); }
        sync_lds();
        if (pass == 0) { *(u32x4*)(blob + SB_DTA + tid * 16) = *(const LAS u32x4*)((const LAS unsigned char*)dts + tid * 16);
            for (int i = tid; i < 1024; i += 512) { const int hl = i >> 7; scs[i] = dts[i] * __expf(acss[hl * 128 + 127] - acss[i]); }
            sync_lds(); }
        { unsigned char* xb = blob + (pass ? SB_XT1 : SB_XT0);
#pragma unroll
          for (int o = 0; o < 8; ++o) *(u32x4*)(xb + tid * 16 + o * 8192) = *(const LAS u32x4*)(XT + tid * 16 + o * 8192); }
        const int hh = F.wave >> 1, nh = F.wave & 1, hl = 4 * pass + hh;
        f32x4 acc[4][4];
#pragma unroll
        for (int pt = 0; pt < 4; ++pt)
#pragma unroll
            for (int nt = 0; nt < 4; ++nt) acc[pt][nt] = (f32x4){0.f, 0.f, 0.f, 0.f};
#pragma unroll 1
        for (int ks = 0; ks < 4; ++ks) { bf16x8 Bf[4], Xf[4];
#pragma unroll
            for (int nt = 0; nt < 4; ++nt) Bf[nt] = ldfrag(BT, 64 * nh + 16 * nt + fr, 4 * ks + fq);
            const f32x4 s0 = *(const LAS f32x4*)(scs + hl * 128 + 32 * ks + 8 * fq), s1 = *(const LAS f32x4*)(scs + hl * 128 + 32 * ks + 8 * fq + 4);
#pragma unroll
            for (int pt = 0; pt < 4; ++pt) { const u32x4 w = *(const LAS u32x4*)(XT + swz(hh * 64 + 16 * pt + fr, 4 * ks + fq));
                const float v[8] = {bflo(w.x) * s0[0], bfhi(w.x) * s0[1], bflo(w.y) * s0[2], bfhi(w.y) * s0[3], bflo(w.z) * s1[0], bfhi(w.z) * s1[1], bflo(w.w) * s1[2], bfhi(w.w) * s1[3]};
                const u32x4 pw = pack8(v); Xf[pt] = __builtin_bit_cast(bf16x8, pw); }
#pragma unroll
            for (int pt = 0; pt < 4; ++pt)
#pragma unroll
                for (int nt = 0; nt < 4; ++nt) acc[pt][nt] = mfma16(Bf[nt], Xf[pt], acc[pt][nt]); }
        const int h = g * 8 + hl; bf16* base = sst + ((size_t)bc * 16 + h) * 8192;
#pragma unroll
        for (int pt = 0; pt < 4; ++pt)
#pragma unroll
            for (int nt = 0; nt < 4; ++nt) { const f32x4 v = acc[pt][nt]; *(u32x2*)(base + (16 * pt + fr) * 128 + 64 * nh + 16 * nt + 4 * fq) = (u32x2){pk2(v[0], v[1]), pk2(v[2], v[3])}; }
        sync_lds();
    }
    if (tid < 8) cdec[(size_t)bc * 16 + g * 8 + tid] = __expf(acss[tid * 128 + 127]);
}

__device__ __forceinline__ float gla_gcs(Frame& F, int tid, int h, int c, const LAS float* alr, LAS float* qtot, const float (&wd)[16], const float bd, float (&gcs)[32]) {
    const int d = tid & 127, tq = tid >> 7;
    float run = 0.f;
#pragma unroll
    for (int i = 0; i < 32; ++i) { const int s = 32 * tq + i; float z = bd;
#pragma unroll
        for (int r4 = 0; r4 < 4; ++r4) { const f32x4 a = *(const LAS f32x4*)(alr + s * 16 + 4 * r4); z += a.x * wd[4 * r4] + a.y * wd[4 * r4 + 1] + a.z * wd[4 * r4 + 2] + a.w * wd[4 * r4 + 3]; }
        const float la = (c * 128 + s < PADROWS) ? 0.f : logsigmoid_f(z) * (1.f / 16.f);
        run += la; gcs[i] = run;
        if ((i & 3) == 3) asm volatile("" ::: "memory"); }
    qtot[tq * 128 + d] = run;
    sync_lds();
    const float q0 = qtot[d], q1 = qtot[128 + d], q2 = qtot[256 + d], q3 = qtot[384 + d];
    const float off = (tq > 0 ? q0 : 0.f) + (tq > 1 ? q1 : 0.f) + (tq > 2 ? q2 : 0.f);
#pragma unroll
    for (int i = 0; i < 32; ++i) gcs[i] += off;
    return (q0 + q1) + (q2 + q3);
}
struct GlaIn { u32x4 rq[4], rk[4]; u32x2 rv[2][8]; unsigned short ra[4]; float wd[16], bd; };
__device__ __forceinline__ void gla_load_qka(const bf16* proj, size_t grow0, int h, int tid, GlaIn& I) {
#pragma unroll
    for (int i = 0; i < 4; ++i) { I.rq[i] = *(const u32x4*)(proj + paddr(grow0 + (tid >> 4), C_Q + h * 128 + 8 * (tid & 15)) + prow16(2 * i)); I.rk[i] = *(const u32x4*)(proj + paddr(grow0 + (tid >> 4), C_K + h * 128 + 8 * (tid & 15)) + prow16(2 * i)); }
#pragma unroll
    for (int i = 0; i < 4; ++i) I.ra[i] = proj[paddr(grow0 + (tid >> 4), C_ALR + (tid & 15)) + prow16(2 * i)];
}
__device__ __forceinline__ void gla_load_v(const bf16* proj, size_t grow0, int h, int tid, GlaIn& I) {
#pragma unroll
    for (int k = 0; k < 2; ++k)
#pragma unroll
        for (int t = 0; t < 8; ++t) I.rv[k][t] = *(const u32x2*)(proj + paddr(grow0 + 8 * (tid >> 6), C_V + h * 256 + 4 * (tid & 63)) + prow16(4 * k) + 8 * t);
}
__device__ __forceinline__ void gla_load_wd(Frame& F, int h, int tid, GlaIn& I) {
#pragma unroll
    for (int r = 0; r < 16; ++r) I.wd[r] = F.w_decay_up[r * 512 + h * 128 + (tid & 127)];
    I.bd = F.b_decay[h * 128 + (tid & 127)];
}
__device__ __forceinline__ void m1_gla(Frame& F, int j, int jn, int un, UQ& Q, GlaIn& I) {
    int tid = threadIdx.x; asm volatile("" : "+v"(tid)); const int lane = tid & 63;
    const int h = j & 3, bc = j >> 2, b = bc / NCHUNK, c = bc % NCHUNK, hn = jn & 3, bcn = jn >> 2;
    const bf16* proj = (const bf16*)(F.ws + WS_PROJ); bf16* gst = (bf16*)(F.ws + WS_GST); float* gdec = (float*)(F.ws + WS_TAB + TAB_GDEC);
    unsigned char* blob = F.ws + WS_GBLOB + (size_t)j * GB_BYTES;
    LAS unsigned char* Qd = F.lds; LAS unsigned char* Ki = F.lds + 32768; LAS unsigned char* KiT = F.lds + 65536; LAS unsigned char* VT = F.lds;
    LAS float* alr = (LAS float*)(F.lds + 98304); LAS float* qtot = alr + 2048; LAS float* egl = qtot + 512;
    const size_t grow0n = (size_t)(bcn / NCHUNK) * LPAD + (bcn % NCHUNK) * 128; const int fr = lane & 15, fq = lane >> 4;
    uq_fetch(F, Q);
#pragma unroll
    for (int i = 0; i < 4; ++i) { const int q = tid + 512 * i, tok = q >> 4, ch = q & 15; *(LAS u32x4*)(Qd + swz(tok, ch)) = I.rq[i]; *(LAS u32x4*)(Ki + swz(tok, ch)) = I.rk[i]; alr[q] = bf2f(I.ra[i]); }
    asm volatile("" ::: "memory");
    gla_load_qka(proj, grow0n, hn, tid, I);
    sync_lds();
    { float gcs[32]; const float glast = gla_gcs(F, tid, h, c, alr, qtot, I.wd, I.bd, gcs); const int d = tid & 127, tq = tid >> 7;
      asm volatile("" ::: "memory");
      gla_load_wd(F, hn, tid, I);
      uq_publish(F, Q, un);
#pragma unroll
      for (int jj = 0; jj < 4; ++jj) { float kt[8];
#pragma unroll
          for (int t = 0; t < 8; ++t) { const int s = 32 * tq + 8 * jj + t; LAS bf16* qp = (LAS bf16*)(Qd + swz(s, d >> 3) + (d & 7) * 2); LAS bf16* kp = (LAS bf16*)(Ki + swz(s, d >> 3) + (d & 7) * 2);
              const float gs = gcs[8 * jj + t]; const float qv = bf2f(*qp) * 0.08838834764831845f * __expf(gs), kv = bf2f(*kp) * __expf(-gs);
              *qp = (bf16)f2bf(qv); const unsigned kb = f2bf(kv); *kp = (bf16)kb; kt[t] = __uint_as_float(kb << 16); }
          *(LAS u32x4*)(KiT + swz(d, 4 * tq + jj)) = pack8(kt); asm volatile("" ::: "memory"); }
      if (tq == 0) { const float e = __expf(glast); egl[d] = e; gdec[(size_t)j * 128 + d] = e; } }
    sync_lds();
#pragma unroll
    for (int o = 0; o < 8; ++o) *(u32x4*)(blob + GB_QD + tid * 16 + o * 8192) = *(const LAS u32x4*)(Qd + tid * 16 + o * 8192);
    sync_lds();
#pragma unroll
    for (int k = 0; k < 2; ++k) { float v[4][8];
#pragma unroll
        for (int t = 0; t < 8; ++t) { const u32x2 w = I.rv[k][t]; v[0][t] = bflo(w.x); v[1][t] = bfhi(w.x); v[2][t] = bflo(w.y); v[3][t] = bfhi(w.y); }
#pragma unroll
        for (int i = 0; i < 4; ++i) *(LAS u32x4*)(VT + swz(4 * (tid & 63) + i, (tid >> 6) + 8 * k)) = pack8(v[i]); }
    asm volatile("" ::: "memory");
    gla_load_v(proj, grow0n, hn, tid, I);
    sync_lds();
#pragma unroll
    for (int o = 0; o < 8; ++o) *(u32x4*)(blob + GB_VT + tid * 16 + o * 8192) = *(const LAS u32x4*)(VT + tid * 16 + o * 8192);
    f32x4 acc[2][8];
#pragma unroll
    for (int vt = 0; vt < 2; ++vt)
#pragma unroll
        for (int dt = 0; dt < 8; ++dt) acc[vt][dt] = (f32x4){0.f, 0.f, 0.f, 0.f};
#pragma unroll 1
    for (int ks = 0; ks < 4; ++ks) { bf16x8 Kf[8], Vf[2];
#pragma unroll
        for (int dt = 0; dt < 8; ++dt) Kf[dt] = ldfrag(KiT, 16 * dt + fr, 4 * ks + fq);
#pragma unroll
        for (int vt = 0; vt < 2; ++vt) Vf[vt] = ldfrag(VT, 32 * F.wave + 16 * vt + fr, 4 * ks + fq);
#pragma unroll
        for (int vt = 0; vt < 2; ++vt)
#pragma unroll
            for (int dt = 0; dt < 8; ++dt) acc[vt][dt] = mfma16(Kf[dt], Vf[vt], acc[vt][dt]); }
    bf16* base = gst + (size_t)j * 32768;
#pragma unroll
    for (int dt = 0; dt < 8; ++dt) { const f32x4 e = *(const LAS f32x4*)(egl + 16 * dt + 4 * fq);
#pragma unroll
        for (int vt = 0; vt < 2; ++vt) { const f32x4 v = acc[vt][dt] * e; *(u32x2*)(base + (32 * F.wave + 16 * vt + fr) * 128 + 16 * dt + 4 * fq) = (u32x2){pk2(v[0], v[1]), pk2(v[2], v[3])}; } }
}
__device__ __forceinline__ void phase_m1(Frame& F, int which) {
    if (which != 0) return;
    { LAS float* cws = (LAS float*)(F.lds + CONVW_OFF);
      for (int i = F.tid; i < 4 * XBCW; i += 512) cws[i] = F.conv_w[i];
      for (int i = F.tid; i < XBCW; i += 512) cws[4 * XBCW + i] = F.conv_b[i];
      if (F.tid < 16) { LAS float* hts = (LAS float*)(F.lds + HEADT_OFF); hts[F.tid] = -__expf(F.a_log[F.tid]); hts[16 + F.tid] = F.dt_bias[F.tid]; }
      __syncthreads(); }
    UQ Q; uq_init(F, Q, (unsigned*)(F.ws + WS_CTL) + CW_Q);
    int u, un; bool more = uq_top(Q, u, un);
    if (more && u < NU_SSD) {
        SsdIn I;
        { int tid = threadIdx.x; asm volatile("" : "+v"(tid)); const int g = u & 1, bc = u >> 1; const long grow0 = (long)(bc / NCHUNK) * LPAD + (bc % NCHUNK) * 128; const bf16* proj = (const bf16*)(F.ws + WS_PROJ);
          ssd_load_dt(proj, grow0, g, F.wave, tid & 63, I);
          conv_load(proj, grow0, 8 * (tid >> 5), 1024 + g * 128 + 4 * (tid & 31), I.rB); conv_load(proj, grow0, 8 * (tid >> 5), 1280 + g * 128 + 4 * (tid & 31), I.rC);
          conv_load(proj, grow0, 8 * (tid >> 6), g * 512 + 4 * (tid & 63), I.rX0); conv_load(proj, grow0, 8 * ((tid >> 6) + 8), g * 512 + 4 * (tid & 63), I.rX1); }
        while (more && u < NU_SSD) {
            uq_fetch(F, Q);
            m1_ssd(F, u, un < NU_SSD ? un : u, I);
            uq_publish(F, Q, un);
            more = uq_top(Q, u, un);
        }
    }
    if (more) {
        GlaIn I;
        { int tid = threadIdx.x; asm volatile("" : "+v"(tid)); const int j = u - NU_SSD, h = j & 3, bc = j >> 2; const size_t grow0 = (size_t)(bc / NCHUNK) * LPAD + (bc % NCHUNK) * 128; const bf16* proj = (const bf16*)(F.ws + WS_PROJ);
          gla_load_qka(proj, grow0, h, tid, I); gla_load_wd(F, h, tid, I); gla_load_v(proj, grow0, h, tid, I); }
        while (more) {
            const int j = u - NU_SSD;
            m1_gla(F, j, (un < NU_ALL ? un : u) - NU_SSD, un, Q, I);
            more = uq_top(Q, u, un);
        }
    }
    __syncthreads();
}

__device__ __forceinline__ void phase_m2(Frame& F, int probe) {
    bf16* sst = (bf16*)(F.ws + (probe ? WS_MIXED : WS_SST)); bf16* gst = (bf16*)(F.ws + (probe ? WS_MIXED + 65 * MiB : WS_GST)); const float* cdec = (const float*)(F.ws + WS_TAB + TAB_CDEC); const float* gdec = (const float*)(F.ws + WS_TAB + TAB_GDEC);
    const int tid = threadIdx.x;
    for (int t = F.bid * 512 + tid; t < 131072; t += F.G * 512) {
        const int type = t >> 16, idx = t & 65535, b = idx >> 14;
        float run[8];
#pragma unroll
        for (int j = 0; j < 8; ++j) run[j] = 0.f;
        if (type == 0) {
            const int n8 = idx & 15, p = (idx >> 4) & 63, h = (idx >> 10) & 15;
#pragma unroll 5
            for (int c = 0; c < NCHUNK; ++c) { u32x4* ptr = (u32x4*)(sst + (((size_t)b * NCHUNK + c) * 16 + h) * 8192 + p * 128 + n8 * 8); const u32x4 w = *ptr; const float dc = cdec[((size_t)b * NCHUNK + c) * 16 + h];
                *ptr = pack8(run);
                run[0] = dc * run[0] + bflo(w.x); run[1] = dc * run[1] + bfhi(w.x); run[2] = dc * run[2] + bflo(w.y); run[3] = dc * run[3] + bfhi(w.y);
                run[4] = dc * run[4] + bflo(w.z); run[5] = dc * run[5] + bfhi(w.z); run[6] = dc * run[6] + bflo(w.w); run[7] = dc * run[7] + bfhi(w.w); }
        } else {
            const int d8 = idx & 15, v = (idx >> 4) & 255, h = (idx >> 12) & 3;
#pragma unroll 5
            for (int c = 0; c < NCHUNK; ++c) { u32x4* ptr = (u32x4*)(gst + (((size_t)b * NCHUNK + c) * 4 + h) * 32768 + v * 128 + d8 * 8); const u32x4 w = *ptr;
                const float* dp = gdec + (((size_t)b * NCHUNK + c) * 4 + h) * 128 + d8 * 8; const f32x4 d0 = *(const f32x4*)dp, d1 = *(const f32x4*)(dp + 4);
                *ptr = pack8(run);
                run[0] = d0.x * run[0] + bflo(w.x); run[1] = d0.y * run[1] + bfhi(w.x); run[2] = d0.z * run[2] + bflo(w.y); run[3] = d0.w * run[3] + bfhi(w.y);
                run[4] = d1.x * run[4] + bflo(w.z); run[5] = d1.y * run[5] + bfhi(w.z); run[6] = d1.z * run[6] + bflo(w.w); run[7] = d1.w * run[7] + bfhi(w.w); }
        }
    }
}

template <int PROBE> __device__ __forceinline__ void m3_ssd_pass(Frame& F, int pass, int b, int c, int g, int lane, const bf16* proj, const bf16* sst, const unsigned char* blob, u32x2 (&ypk)[4][4]) {
    LAS unsigned char* Cn = F.lds; LAS unsigned char* CB = F.lds + 32768; LAS unsigned char* XT = F.lds + 65536;
    LAS float* dts = (LAS float*)(F.lds + 131072); LAS float* acss = dts + 1024; LAS float* ssp = acss + 1024;
    const long grow0 = (long)b * LPAD + c * 128; const int fr = lane & 15, fq = lane >> 4;
    const int hh = F.wave & 3, lh = F.wave >> 2;
    const int hl = 4 * pass + hh, h = g * 8 + hl; const float dsk = F.d_skip[h];
    const bf16* hp = sst + (((size_t)b * NCHUNK + c) * 16 + h) * 8192;
    bf16x8 Hf[4][4];
#pragma unroll
    for (int ks = 0; ks < 4; ++ks)
#pragma unroll
        for (int pt = 0; pt < 4; ++pt) Hf[ks][pt] = *(const bf16x8*)(hp + (16 * pt + fr) * 128 + 32 * ks + 8 * fq);
    blob_in(blob + (pass ? SB_XT1 : SB_XT0), XT, 65536, F.wave, lane);
    f32x4 acc[4][4];
#pragma unroll
    for (int pt = 0; pt < 4; ++pt)
#pragma unroll
        for (int i = 0; i < 4; ++i) acc[pt][i] = (f32x4){0.f, 0.f, 0.f, 0.f};
    if (PROBE == 1) { asm volatile("" :: "v"(Hf[0][0]), "v"(Hf[1][1]), "v"(Hf[2][2]), "v"(Hf[3][3])); }
    else
#pragma unroll
    for (int ks = 0; ks < 4; ++ks) { bf16x8 Cf[4];
#pragma unroll
        for (int i = 0; i < 4; ++i) Cf[i] = ldfrag(Cn, 16 * (2 * i + lh) + fr, 4 * ks + fq);
#pragma unroll
        for (int pt = 0; pt < 4; ++pt)
#pragma unroll
            for (int i = 0; i < 4; ++i) acc[pt][i] = mfma16(Hf[ks][pt], Cf[i], acc[pt][i]);
        asm volatile("" ::: "memory"); }
    float al[4];
#pragma unroll
    for (int i = 0; i < 4; ++i) { al[i] = acss[hl * 128 + 16 * (2 * i + lh) + fr]; const float e = __expf(al[i]);
#pragma unroll
        for (int pt = 0; pt < 4; ++pt) acc[pt][i] = acc[pt][i] * e; }
    asm volatile("s_waitcnt vmcnt(0)" ::: "memory");
    sync_lds();
    if (PROBE != 1)
#pragma unroll 1
    for (int ks = 0; ks < 4; ++ks) { bf16x8 Xf[4];
#pragma unroll
        for (int pt = 0; pt < 4; ++pt) Xf[pt] = ldfrag(XT, hh * 64 + 16 * pt + fr, 4 * ks + fq);
        const f32x4 as0 = *(const LAS f32x4*)(acss + hl * 128 + 32 * ks + 8 * fq), as1 = *(const LAS f32x4*)(acss + hl * 128 + 32 * ks + 8 * fq + 4);
        const f32x4 dt0 = *(const LAS f32x4*)(dts + hl * 128 + 32 * ks + 8 * fq), dt1 = *(const LAS f32x4*)(dts + hl * 128 + 32 * ks + 8 * fq + 4);
#pragma unroll
        for (int i = 0; i < 4; ++i) if (ks <= i) { const int l = 16 * (2 * i + lh) + fr;
            const u32x4 cw = *(const LAS u32x4*)(CB + swz(l, 4 * ks + fq));
            const float cbv[8] = {bflo(cw.x), bfhi(cw.x), bflo(cw.y), bfhi(cw.y), bflo(cw.z), bfhi(cw.z), bflo(cw.w), bfhi(cw.w)};
            float m[8];
#pragma unroll
            for (int j = 0; j < 8; ++j) { const int s = 32 * ks + 8 * fq + j; const float asj = j < 4 ? as0[j & 3] : as1[j & 3], dtj = j < 4 ? dt0[j & 3] : dt1[j & 3];
                float v = (s <= l) ? cbv[j] * __expf(al[i] - asj) * dtj : 0.f; if (s == l) v += dsk; m[j] = v; }
            const u32x4 mw = pack8(m); const bf16x8 Mf = __builtin_bit_cast(bf16x8, mw);
#pragma unroll
            for (int pt = 0; pt < 4; ++pt) acc[pt][i] = mfma16(Xf[pt], Mf, acc[pt][i]); } }
    u32x2 zw[4][4];
#pragma unroll
    for (int i = 0; i < 4; ++i)
#pragma unroll
        for (int pt = 0; pt < 4; ++pt) zw[i][pt] = *(const u32x2*)(proj + paddr(grow0 + 16 * lh + fr, C_Z + h * 64 + 4 * fq) + prow16(2 * i) + (pt >> 1) * 8192 + (pt & 1) * 256);
#pragma unroll
    for (int i = 0; i < 4; ++i) { const int l = 16 * (2 * i + lh) + fr; float ss = 0.f;
#pragma unroll
        for (int pt = 0; pt < 4; ++pt) { const u32x2 z2 = zw[i][pt];
            f32x4 y = acc[pt][i]; y[0] *= silu_f(bflo(z2.x)); y[1] *= silu_f(bfhi(z2.x)); y[2] *= silu_f(bflo(z2.y)); y[3] *= silu_f(bfhi(z2.y));
            const u32x2 yw = (u32x2){pk2(y[0], y[1]), pk2(y[2], y[3])}; ypk[pt][i] = yw;
            const float r0 = bflo(yw.x), r1 = bfhi(yw.x), r2 = bflo(yw.y), r3 = bfhi(yw.y); ss += (r0 * r0 + r1 * r1) + (r2 * r2 + r3 * r3); }
        ss += __shfl_xor(ss, 16); ss += __shfl_xor(ss, 32);
        if (fq == 0) ssp[(pass * 4 + hh) * 128 + l] = ss; }
    asm volatile("s_waitcnt lgkmcnt(0)" ::: "memory");
    sync_lds();
}
template <int PROBE> __device__ __forceinline__ void m3_ssd(Frame& F, int b, int c, int g, bool pre, int un, int une, UQ& Q) {
    int tid = threadIdx.x; asm volatile("" : "+v"(tid)); const int lane = tid & 63;
    const bf16* proj = (const bf16*)(F.ws + WS_PROJ); const bf16* sst = (const bf16*)(F.ws + WS_SST); bf16* mixed = (bf16*)(F.ws + WS_MIXED);
    const unsigned char* blob = (const unsigned char*)F.out + ((size_t)(b * NCHUNK + c) * 2 + g) * SB_BYTES;
    LAS unsigned char* Cn = F.lds; LAS unsigned char* CB = F.lds + 32768; LAS unsigned char* Bn = F.lds + 65536;
    LAS float* dts = (LAS float*)(F.lds + 131072); LAS float* ssp = dts + 2048;
    const long grow0 = (long)b * LPAD + c * 128; const int fr = lane & 15, fq = lane >> 4;
    const int hh = F.wave & 3, lh = F.wave >> 2;
    if (pre) asm volatile("s_waitcnt vmcnt(24)" ::: "memory");
    else { blob_in(blob + SB_CN, Cn, 32768, F.wave, lane); blob_in(blob + SB_BN, Bn, 32768, F.wave, lane); blob_in(blob + SB_DTA, (LAS unsigned char*)dts, 8192, F.wave, lane);
           asm volatile("s_waitcnt vmcnt(0)" ::: "memory"); }
    sync_lds();
    uq_fetch(F, Q);
    {
        const int lt = F.wave; f32x4 cb[8];
#pragma unroll
        for (int st = 0; st < 8; ++st) cb[st] = (f32x4){0.f, 0.f, 0.f, 0.f};
        if (PROBE != 1)
#pragma unroll
        for (int ks = 0; ks < 4; ++ks) { const bf16x8 Cf = ldfrag(Cn, 16 * lt + fr, 4 * ks + fq);
#pragma unroll
            for (int st = 0; st < 8; ++st) if (st <= lt) { const bf16x8 Bf = ldfrag(Bn, 16 * st + fr, 4 * ks + fq); cb[st] = mfma16(Bf, Cf, cb[st]); } }
        asm volatile("s_waitcnt lgkmcnt(0)" ::: "memory");
        sync_lds();
#pragma unroll
        for (int st = 0; st < 8; ++st) if (st <= lt) *(LAS u32x2*)(CB + swz(16 * lt + fr, 2 * st + (fq >> 1)) + (fq & 1) * 8) = (u32x2){pk2(cb[st][0], cb[st][1]), pk2(cb[st][2], cb[st][3])};
    }
    u32x2 y0[4][4], y1[4][4];
    m3_ssd_pass<PROBE>(F, 0, b, c, g, lane, proj, sst, blob, y0);
    m3_ssd_pass<PROBE>(F, 1, b, c, g, lane, proj, sst, blob, y1);
    uq_publish(F, Q, un);
    f32x4 nw[2][4];
#pragma unroll
    for (int pass = 0; pass < 2; ++pass)
#pragma unroll
        for (int pt = 0; pt < 4; ++pt) nw[pass][pt] = *(const f32x4*)(F.ssd_norm_w + g * 512 + (4 * pass + hh) * 64 + 16 * pt + 4 * fq);
    asm volatile("" ::: "memory");
    { const unsigned char* nblob = (const unsigned char*)F.out + (size_t)une * SB_BYTES;
      blob_in(nblob + SB_CN, Cn, 32768, F.wave, lane); blob_in(nblob + SB_BN, Bn, 32768, F.wave, lane); blob_in(nblob + SB_DTA, (LAS unsigned char*)dts, 8192, F.wave, lane); }
    asm volatile("" ::: "memory");
    if (PROBE == 0)
#pragma unroll
    for (int i = 0; i < 4; ++i) { const int l = 16 * (2 * i + lh) + fr; float tot = 0.f;
#pragma unroll
        for (int k = 0; k < 8; ++k) tot += ssp[k * 128 + l];
        const float rstd = rsqrtf(tot * (1.f / 512.f) + EPS);
#pragma unroll
        for (int pass = 0; pass < 2; ++pass)
#pragma unroll
            for (int pt = 0; pt < 4; ++pt) { const int col = g * 512 + (4 * pass + hh) * 64 + 16 * pt + 4 * fq; const f32x4 w = nw[pass][pt];
                const u32x2 yw = pass ? y1[pt][i] : y0[pt][i];
                *(u32x2*)(mixed + (size_t)(grow0 + l) * MIXW + col) = (u32x2){pk2(bflo(yw.x) * rstd * w[0], bfhi(yw.x) * rstd * w[1]), pk2(bflo(yw.y) * rstd * w[2], bfhi(yw.y) * rstd * w[3])}; } }
    else { asm volatile("" :: "v"(y0[0][0]), "v"(y0[3][3]), "v"(y1[0][0]), "v"(y1[3][3])); }
}

template <int PROBE> __device__ __forceinline__ void m3_gla(Frame& F, int b, int c, int h, bool pre, int un, int une, bf16x8 (&Sf)[4][2], UQ& Q) {
    int tid = threadIdx.x; asm volatile("" : "+v"(tid)); const int lane = tid & 63;
    const bf16* proj = (const bf16*)(F.ws + WS_PROJ); const bf16* gst = (const bf16*)(F.ws + WS_GST); bf16* mixed = (bf16*)(F.ws + WS_MIXED);
    const unsigned char* blob = F.ws + WS_GBLOB + ((size_t)(b * NCHUNK + c) * 4 + h) * GB_BYTES;
    LAS unsigned char* Qd = F.lds; LAS unsigned char* Ki = F.lds + 32768; LAS unsigned char* P = F.lds + 32768; LAS unsigned char* VT = F.lds + 65536;
    LAS float* ssp = (LAS float*)(F.lds + 131072);
    const size_t grow0 = (size_t)b * LPAD + c * 128; const int fr = lane & 15, fq = lane >> 4;
    if (pre) asm volatile("s_waitcnt vmcnt(12)" ::: "memory");
    else { const bf16* sp = gst + (((size_t)b * NCHUNK + c) * 4 + h) * 32768;
#pragma unroll
        for (int ks = 0; ks < 4; ++ks)
#pragma unroll
            for (int vt = 0; vt < 2; ++vt) Sf[ks][vt] = *(const bf16x8*)(sp + (32 * F.wave + 16 * vt + fr) * 128 + 32 * ks + 8 * fq);
        blob_in(blob, Qd, 131072, F.wave, lane);
        asm volatile("s_waitcnt vmcnt(0)" ::: "memory"); }
    sync_lds();
    uq_fetch(F, Q);
    {
        const int lt = F.wave; f32x4 sc[8];
#pragma unroll
        for (int st = 0; st < 8; ++st) sc[st] = (f32x4){0.f, 0.f, 0.f, 0.f};
        if (PROBE != 1)
#pragma unroll
        for (int ks = 0; ks < 4; ++ks) { const bf16x8 Qf = ldfrag(Qd, 16 * lt + fr, 4 * ks + fq);
#pragma unroll
            for (int st = 0; st < 8; ++st) if (st <= lt) { const bf16x8 Kf = ldfrag(Ki, 16 * st + fr, 4 * ks + fq); sc[st] = mfma16(Kf, Qf, sc[st]); } }
        asm volatile("s_waitcnt lgkmcnt(0)" ::: "memory");
        sync_lds();
        const int l = 16 * lt + fr;
#pragma unroll
        for (int st = 0; st < 8; ++st) if (st <= (lt | 1)) { float v[4];
#pragma unroll
            for (int r = 0; r < 4; ++r) { const int s = 16 * st + 4 * fq + r; v[r] = (st <= lt && s <= l) ? sc[st][r] : 0.f; }
            *(LAS u32x2*)(P + swz(l, 2 * st + (fq >> 1)) + (fq & 1) * 8) = (u32x2){pk2(v[0], v[1]), pk2(v[2], v[3])}; }
    }
    f32x4 acc[2][8];
#pragma unroll
    for (int vt = 0; vt < 2; ++vt)
#pragma unroll
        for (int lt = 0; lt < 8; ++lt) acc[vt][lt] = (f32x4){0.f, 0.f, 0.f, 0.f};
    if (PROBE == 1) { asm volatile("" :: "v"(Sf[0][0]), "v"(Sf[1][1]), "v"(Sf[2][0]), "v"(Sf[3][1])); }
    else
#pragma unroll
    for (int ks = 0; ks < 4; ++ks) { bf16x8 Qf[8];
#pragma unroll
        for (int lt = 0; lt < 8; ++lt) Qf[lt] = ldfrag(Qd, 16 * lt + fr, 4 * ks + fq);
#pragma unroll
        for (int vt = 0; vt < 2; ++vt)
#pragma unroll
            for (int lt = 0; lt < 8; ++lt) acc[vt][lt] = mfma16(Sf[ks][vt], Qf[lt], acc[vt][lt]);
        asm volatile("" ::: "memory"); }
    u32x2 gw[8][2];
#pragma unroll
    for (int lt = 0; lt < 8; ++lt)
#pragma unroll
        for (int vt = 0; vt < 2; ++vt) gw[lt][vt] = *(const u32x2*)(proj + paddr(grow0 + fr, C_G + h * 256 + 32 * F.wave + 16 * vt + 4 * fq) + prow16(lt));
    sync_lds();
    if (PROBE != 1)
#pragma unroll 1
    for (int ks = 0; ks < 4; ++ks) { bf16x8 Vf[2];
#pragma unroll
        for (int vt = 0; vt < 2; ++vt) Vf[vt] = ldfrag(VT, 32 * F.wave + 16 * vt + fr, 4 * ks + fq);
#pragma unroll
        for (int lt = 0; lt < 8; ++lt) if (2 * ks <= lt) { const bf16x8 Pf = ldfrag(P, 16 * lt + fr, 4 * ks + fq);
#pragma unroll
            for (int vt = 0; vt < 2; ++vt) acc[vt][lt] = mfma16(Vf[vt], Pf, acc[vt][lt]); } }
#pragma unroll
    for (int lt = 0; lt < 8; ++lt) { float ss = 0.f;
#pragma unroll
        for (int vt = 0; vt < 2; ++vt) { const f32x4 y = acc[vt][lt]; ss += (y[0] * y[0] + y[1] * y[1]) + (y[2] * y[2] + y[3] * y[3]); }
        ss += __shfl_xor(ss, 16); ss += __shfl_xor(ss, 32);
        if (fq == 0) ssp[F.wave * 128 + 16 * lt + fr] = ss; }
    sync_lds();
    uq_publish(F, Q, un);
    f32x4 nw[2];
#pragma unroll
    for (int vt = 0; vt < 2; ++vt) nw[vt] = *(const f32x4*)(F.gla_norm_w + 32 * F.wave + 16 * vt + 4 * fq);
    asm volatile("" ::: "memory");
    { const bf16* sp = gst + (size_t)une * 32768;
#pragma unroll
      for (int ks = 0; ks < 4; ++ks)
#pragma unroll
          for (int vt = 0; vt < 2; ++vt) Sf[ks][vt] = *(const bf16x8*)(sp + (32 * F.wave + 16 * vt + fr) * 128 + 32 * ks + 8 * fq);
      blob_in(F.ws + WS_GBLOB + (size_t)une * GB_BYTES, Qd, 131072, F.wave, lane); }
    asm volatile("" ::: "memory");
#pragma unroll
    for (int lt = 0; lt < 8; ++lt) { const int l = 16 * lt + fr; float tot = 0.f;
#pragma unroll
        for (int k = 0; k < 8; ++k) tot += ssp[k * 128 + l];
        const float rstd = rsqrtf(tot * (1.f / 256.f) + EPS);
#pragma unroll
        for (int vt = 0; vt < 2; ++vt) { const int vv = 32 * F.wave + 16 * vt + 4 * fq; const f32x4 w = nw[vt]; const f32x4 y = acc[vt][lt]; const u32x2 g2 = gw[lt][vt];
            const u32x2 ow = (u32x2){pk2(y[0] * rstd * w[0] * silu_f(bflo(g2.x)), y[1] * rstd * w[1] * silu_f(bfhi(g2.x))), pk2(y[2] * rstd * w[2] * silu_f(bflo(g2.y)), y[3] * rstd * w[3] * silu_f(bfhi(g2.y)))};
            if (PROBE == 0) *(u32x2*)(mixed + (grow0 + l) * MIXW + 1024 + h * 256 + vv) = ow; else asm volatile("" :: "v"(ow)); } }
}
__device__ __forceinline__ void phase_m3(Frame& F, int which) {
    if (which != 0) return;
    UQ Q; uq_init(F, Q, (unsigned*)(F.ws + WS_CTL) + CW_Q + 64);
    int u, un; bool more = uq_top(Q, u, un), pre = false;
    while (more && u < NU_SSD) {
        const bool nx = un < NU_SSD; const int g = u & 1, bc = u >> 1;
        m3_ssd<0>(F, bc / NCHUNK, bc % NCHUNK, g, pre, un, nx ? un : u, Q);
        pre = nx; more = uq_top(Q, u, un);
    }
    asm volatile("s_waitcnt vmcnt(0)" ::: "memory");
    __syncthreads();
    bf16x8 Sf[4][2];
#pragma unroll
    for (int ks = 0; ks < 4; ++ks)
#pragma unroll
        for (int vt = 0; vt < 2; ++vt) Sf[ks][vt] = (bf16x8){0, 0, 0, 0, 0, 0, 0, 0};
    pre = false;
    while (more) {
        const bool nx = un < NU_ALL; const int j = u - NU_SSD, h = j & 3, bc = j >> 2;
        m3_gla<0>(F, bc / NCHUNK, bc % NCHUNK, h, pre, un, (nx ? un : u) - NU_SSD, Sf, Q);
        pre = nx; more = uq_top(Q, u, un);
    }
    asm volatile("s_waitcnt vmcnt(0)" ::: "memory");
    __syncthreads();
}

template <int N> __device__ __forceinline__ int ror16i(int v) { return __builtin_amdgcn_update_dpp(0, v, 0x120 + N, 0xf, 0xf, false); }
template <int N> __device__ __forceinline__ float ror16(float v) { return __int_as_float(ror16i<N>(__float_as_int(v))); }
__device__ __forceinline__ void phase_router(Frame& F, int probe) {
    const LAS f32x4* img = (const LAS f32x4*)F.lds;
    LAS int* sel_e = (LAS int*)(F.lds + MISC_OFF + 1024);
    LAS int* sel_rank = sel_e + 512;
    LAS int* hist = sel_rank + 512;
    LAS int* base = hist + 32;
    const bf16* h1 = (const bf16*)(F.ws + WS_H1B); unsigned char* T = F.ws + WS_T;
    float* gates = (float*)(F.ws + WS_TAB + TAB_GATES); int* pe = (int*)(F.ws + WS_TAB + TAB_PE); int* ps = (int*)(F.ws + WS_TAB + TAB_PS); int* list = (int*)(F.ws + WS_TAB + TAB_LIST);
    unsigned* gcnt = (unsigned*)(F.ws + WS_CTL) + CW_CNT;
    __syncthreads();
    for (int q = F.tid; q < 1024 * 8; q += 512) { const int k = q >> 3, e4 = q & 7; const f32x4 w = ((const f32x4*)F.w_router)[q]; const float nwk = F.ffn_norm_w[k];
        LAS float* dst = (LAS float*)F.lds + ((((((k >> 5) * 2 + (e4 >> 2)) * 2 + ((k >> 2) & 1)) * 64 + ((k >> 3) & 3) * 16 + 4 * (e4 & 3)) * 4) + (k & 3));
        dst[0] = w.x * nwk; dst[4] = w.y * nwk; dst[8] = w.z * nwk; dst[12] = w.w * nwk; }
    const int n = F.lane & 15, qd = F.lane >> 4;
    const float b0 = F.b_router[n], b1 = F.b_router[16 + n];
    for (int blk = F.bid; blk < NTOK / 128; blk += F.G) {
        __syncthreads();
        if (F.tid < 32) hist[F.tid] = 0;
        const int row0 = blk * 128 + F.wave * 16;
        const u32x4* xp = (const u32x4*)(h1 + (size_t)(row0 + n) * D) + qd;
        u32x4 xv[8];
#pragma unroll
        for (int p = 0; p < 8; ++p) xv[p] = xp[4 * p];
        f32x4 acc0 = {0.f, 0.f, 0.f, 0.f}, acc1 = {0.f, 0.f, 0.f, 0.f}; float ss = 0.f;
#pragma unroll 1
        for (int S0 = 0; S0 < 32; S0 += 8) {
#pragma unroll
            for (int p = 0; p < 8; ++p) {
                const u32x4 v = xv[p]; const int Sn = S0 + p + 8; xv[p] = xp[4 * (Sn < 32 ? Sn : 31)];
                __builtin_amdgcn_sched_barrier(0);
                const float f[8] = {bflo(v.x), bfhi(v.x), bflo(v.y), bfhi(v.y), bflo(v.z), bfhi(v.z), bflo(v.w), bfhi(v.w)};
                ss += ((f[0] * f[0] + f[1] * f[1]) + (f[2] * f[2] + f[3] * f[3])) + ((f[4] * f[4] + f[5] * f[5]) + (f[6] * f[6] + f[7] * f[7]));
                const LAS f32x4* ip = img + (S0 + p) * 256 + F.lane;
#pragma unroll
                for (int hf = 0; hf < 2; ++hf) { const f32x4 w0 = ip[hf * 64], w1 = ip[128 + hf * 64];
#pragma unroll
                    for (int j = 0; j < 4; ++j) { acc0 = __builtin_amdgcn_mfma_f32_16x16x4f32(f[4 * hf + j], w0[j], acc0, 0, 0, 0); acc1 = __builtin_amdgcn_mfma_f32_16x16x4f32(f[4 * hf + j], w1[j], acc1, 0, 0, 0); } }
            }
        }
        ss += __shfl_xor(ss, 16); ss += __shfl_xor(ss, 32);
        const float rstd = rsqrtf(ss * (1.f / D) + EPS);
#pragma unroll
        for (int reg = 0; reg < 4; ++reg) {
            const float rs = __shfl(rstd, 4 * qd + reg);
            float v0 = acc0[reg] * rs + b0, v1 = acc1[reg] * rs + b1;
            float tl[4]; int te[4];
#pragma unroll
            for (int k = 0; k < 4; ++k) {
                float m = fmaxf(v0, v1);
                m = fmaxf(m, ror16<8>(m)); m = fmaxf(m, ror16<4>(m)); m = fmaxf(m, ror16<2>(m)); m = fmaxf(m, ror16<1>(m));
                int idx = (v0 == m) ? n : ((v1 == m) ? 16 + n : 64);
                idx = min(idx, ror16i<8>(idx)); idx = min(idx, ror16i<4>(idx)); idx = min(idx, ror16i<2>(idx)); idx = min(idx, ror16i<1>(idx));
                tl[k] = m; te[k] = idx;
                if (idx == n) v0 = -INFINITY;
                if (idx == 16 + n) v1 = -INFINITY;
            }
            const float e1 = __expf(tl[1] - tl[0]), e2 = __expf(tl[2] - tl[0]), e3 = __expf(tl[3] - tl[0]); const float inv = 1.f / (1.f + e1 + e2 + e3);
            if (n == 0) { const int lr = F.wave * 16 + 4 * qd + reg; *(f32x4*)(gates + (size_t)(row0 + 4 * qd + reg) * 4) = (f32x4){inv, e1 * inv, e2 * inv, e3 * inv};
#pragma unroll
                for (int k = 0; k < 4; ++k) sel_e[lr * 4 + k] = te[k]; }
        }
        { const f32x4* nwp = (const f32x4*)F.ffn_norm_w + 2 * F.lane; f32x4 nw[2][2];
#pragma unroll
          for (int j = 0; j < 2; ++j) { nw[j][0] = nwp[128 * j]; nw[j][1] = nwp[128 * j + 1]; }
#pragma unroll 4
          for (int rr = 0; rr < 16; ++rr) {
              const float rs = __shfl(rstd, rr);
              const u32x4* xr = (const u32x4*)(h1 + (size_t)(row0 + rr) * D) + F.lane; u32x2* oa = (u32x2*)(T + (size_t)(row0 + rr) * D) + F.lane;
#pragma unroll
              for (int j = 0; j < 2; ++j) { const u32x4 v = xr[64 * j]; const f32x4 wa = nw[j][0], wb = nw[j][1];
                  oa[64 * j] = (u32x2){pk4_fp8(bflo(v.x) * rs * wa.x, bfhi(v.x) * rs * wa.y, bflo(v.y) * rs * wa.z, bfhi(v.y) * rs * wa.w), pk4_fp8(bflo(v.z) * rs * wb.x, bfhi(v.z) * rs * wb.y, bflo(v.w) * rs * wb.z, bfhi(v.w) * rs * wb.w)}; } } }
        __syncthreads();
        if (probe) continue;
        { const int e = sel_e[F.tid]; sel_rank[F.tid] = __hip_atomic_fetch_add((int*)(hist + e), 1, __ATOMIC_RELAXED, __HIP_MEMORY_SCOPE_WORKGROUP); }
        __syncthreads();
        if (F.tid < 32) base[F.tid] = (int)__hip_atomic_fetch_add(gcnt + F.tid, (unsigned)hist[F.tid], __ATOMIC_RELAXED, __HIP_MEMORY_SCOPE_AGENT);
        __syncthreads();
        { const int e = sel_e[F.tid], slot = base[e] + sel_rank[F.tid], row = blk * 128 + (F.tid >> 2);
          list[e * NTOK + slot] = row; pe[(size_t)row * 4 + (F.tid & 3)] = e; ps[(size_t)row * 4 + (F.tid & 3)] = slot; }
    }
    __syncthreads();
}

__device__ __forceinline__ void phase_combine(Frame& F, int probe) {
    moe_tables(F);
    const LAS int* ts = (const LAS int*)(F.lds + MISC_OFF + 256);
    const bf16* yp = (const bf16*)(F.ws + WS_YPAIR); const float* gates = (const float*)(F.ws + WS_TAB + TAB_GATES); const int* pe = (const int*)(F.ws + WS_TAB + TAB_PE); const int* ps = (const int*)(F.ws + WS_TAB + TAB_PS);
    const int gw = F.bid * 8 + F.wave, NGW = F.G * 8;
    for (int row = gw; row < NTOK; row += NGW) {
        f32x4* xr = (f32x4*)(F.out + (size_t)row * D) + F.lane;
        const u32x2* hr = (const u32x2*)((const bf16*)(F.ws + WS_H1B) + (size_t)row * D) + F.lane;
        f32x4 v[4];
#pragma unroll
        for (int j = 0; j < 4; ++j) { const u32x2 w = hr[64 * j]; v[j] = (f32x4){bflo(w.x), bfhi(w.x), bflo(w.y), bfhi(w.y)}; }
        const f32x4 gt = *(const f32x4*)(gates + (size_t)row * 4);
#pragma unroll
        for (int k = 0; k < 4; ++k) { const int e = pe[(size_t)row * 4 + k], slot = ps[(size_t)row * 4 + k]; const float gk = gt[k];
            const unsigned* yr = (const unsigned*)((const unsigned char*)yp + ((size_t)ts[e] * 256 + slot) * D) + F.lane;
#pragma unroll
            for (int j = 0; j < 4; ++j) { const unsigned w = yr[64 * j]; const f32x2 lo = __builtin_amdgcn_cvt_pk_f32_fp8(w, false), hi = __builtin_amdgcn_cvt_pk_f32_fp8(w, true);
                v[j].x += gk * lo[0]; v[j].y += gk * lo[1]; v[j].z += gk * hi[0]; v[j].w += gk * hi[1]; } }
        float s = 0.f;
#pragma unroll
        for (int j = 0; j < 4; ++j) s += (v[j].x * v[j].x + v[j].y * v[j].y) + (v[j].z * v[j].z + v[j].w * v[j].w);
        const float rstd = rsqrtf(wave_sum(s) * (1.f / D) + EPS);
        const f32x4* nw = (const f32x4*)F.final_norm_w + F.lane;
#pragma unroll
        for (int j = 0; j < 4; ++j) { const f32x4 w = nw[64 * j]; f32x4* dst = probe ? (f32x4*)(F.ws + WS_ACT + (size_t)row * D * 4) + F.lane : xr; dst[64 * j] = (f32x4){v[j].x * rstd * w.x, v[j].y * rstd * w.y, v[j].z * rstd * w.z, v[j].w * rstd * w.w}; }
    }
}

__device__ __forceinline__ bool refresh_ids(Frame& F) { int t = threadIdx.x; asm volatile("" : "+v"(t)); F.tid = t; F.lane = t & 63; return true; }
constexpr int N_PHASES = 10;
#ifndef NAIVE_MIXER
#define NAIVE_MIXER 0
#endif
#ifndef N_LAUNCHES
#define N_LAUNCHES 1
#endif
__global__ void __launch_bounds__(512, 2) hymba_fwd(Args args) {
    extern __shared__ __attribute__((aligned(16))) unsigned char lds_raw[];
    Frame F;
    F.lds = (LAS unsigned char*)lds_raw; F.ws = args.ws; F.tid = threadIdx.x; F.lane = F.tid & 63; F.wave = __builtin_amdgcn_readfirstlane(F.tid >> 6); F.G = gridDim.x; F.bid = blockIdx.x;
    F.x = args.in[0]; F.meta = args.in[1]; F.mix_norm_w = args.in[2]; F.w_in = args.in[3]; F.conv_w = args.in[4]; F.conv_b = args.in[5]; F.dt_bias = args.in[6]; F.a_log = args.in[7]; F.d_skip = args.in[8];
    F.ssd_norm_w = args.in[9]; F.w_decay_up = args.in[10]; F.b_decay = args.in[11]; F.gla_norm_w = args.in[12]; F.w_out = args.in[13]; F.ffn_norm_w = args.in[14]; F.w_router = args.in[15]; F.b_router = args.in[16];
    F.w_gate_up = args.in[17]; F.b_gate_up = args.in[18]; F.w_down = args.in[19]; F.b_down = args.in[20]; F.final_norm_w = args.in[21]; F.out = args.out;
    const int lo = args.ph_lo, hi = args.ph_hi;
    volatile LAS unsigned* bst = (volatile LAS unsigned*)(F.lds + LDS_BYTES - 16);
    if (F.tid < 4) bst[F.tid] = 0u;
    __syncthreads();
    XcdBarrier bar; bar.bar = (unsigned*)(F.ws + WS_CTL) + CW_BAR; bar.x = 0; bar.st = bst;
    if (hi - lo > 1) bar = xcd_barrier_post((unsigned*)(F.ws + WS_CTL) + CW_BAR, bst);
#ifndef PH_MASK
#define PH_MASK 0x3ff
#endif
#define IN(k) (((PH_MASK >> (k)) & 1) && lo <= (k) && (k) < hi && refresh_ids(F))
#ifndef DUP_MASK
#define DUP_MASK 0x0
#endif
#define DUP(k) ((DUP_MASK >> (k)) & 1)
#ifndef DUP_WHICH
#define DUP_WHICH 0
#endif
#ifndef EXTRA_BARS
#define EXTRA_BARS 0
#endif
#define SEAM(k) do { if (IN(k) && IN((k) + 1)) { xcd_barrier(bar); for (int _e = 0; _e < EXTRA_BARS; ++_e) xcd_barrier(bar); } } while (0)
    if (IN(0)) { phase_prep(F); if (DUP(0)) phase_prep(F); }
    SEAM(0);
    if (IN(1)) { phase_inproj(F, true); if (DUP(1)) phase_inproj(F, false); }
    SEAM(1);
#if NAIVE_MIXER
    if (IN(2)) phase_ssd_naive(F);
    if (IN(3)) phase_gla_naive(F);
    SEAM(3);
    if (IN(4)) phase_mixnorm(F);
    SEAM(4);
#else
    if (IN(2)) { phase_m1(F, 0); if (DUP(2)) phase_m1(F, DUP_WHICH); }
    SEAM(2);
    if (IN(3)) { phase_m2(F, 0); if (DUP(3)) phase_m2(F, 1); }
    SEAM(3);
    if (IN(4)) { phase_m3(F, 0); if (DUP(4)) phase_m3(F, DUP_WHICH); }
    SEAM(4);
#endif
    if (IN(5)) { phase_outproj(F); if (DUP(5)) phase_outproj(F); }
    SEAM(5);
    if (IN(6)) { phase_router(F, 0); if (DUP(6)) phase_router(F, 1); }
    SEAM(6);
    if (IN(7)) { phase_gateup(F); if (DUP(7)) phase_gateup(F); }
    SEAM(7);
    if (IN(8)) { if (DUP(8)) phase_down(F, DUP_WHICH); phase_down(F, 1); }
    SEAM(8);
    if (IN(9)) { if (DUP(9)) phase_combine(F, 1); phase_combine(F, 0); }
#undef SEAM
#undef IN
}

extern "C" void kernel_launch(void* const* d_in, const int* in_sizes, int n_in, void* d_out, int out_size, void* d_ws, size_t ws_size, hipStream_t stream) {
    static int grid = 0;
    if (grid == 0) {
        if (n_in != 22 || out_size != NTOK * D || ws_size < WS_END) { fprintf(stderr, "kernel_launch: unexpected shapes (n_in %d out %d ws %zu)\n", n_in, out_size, ws_size); grid = -1; return; }
        int dev = 0, cus = 0;
        if (hipGetDevice(&dev) != hipSuccess || hipDeviceGetAttribute(&cus, hipDeviceAttributeMultiprocessorCount, dev) != hipSuccess) { grid = -1; return; }
        if (hipFuncSetAttribute((const void*)hymba_fwd, hipFuncAttributeMaxDynamicSharedMemorySize, LDS_BYTES) != hipSuccess) { fprintf(stderr, "kernel_launch: hipFuncSetAttribute failed\n"); grid = -1; return; }
        int per_cu = 0;
        if (hipOccupancyMaxActiveBlocksPerMultiprocessor(&per_cu, (const void*)hymba_fwd, 512, LDS_BYTES) != hipSuccess || per_cu < 1) { fprintf(stderr, "kernel_launch: occupancy query says %d blocks per CU\n", per_cu); (void)hipGetLastError(); }
        grid = cus;
    }
    if (grid < 0) return;
    (void)hipMemsetAsync((char*)d_ws + WS_CTL, 0, CTL_ZERO_BYTES, stream);
    Args a{};
    for (int i = 0; i < 22; ++i) a.in[i] = (const float*)d_in[i];
    a.out = (float*)d_out; a.ws = (unsigned char*)d_ws;
#if N_LAUNCHES == 1
    a.ph_lo = 0; a.ph_hi = N_PHASES; hipLaunchKernelGGL(hymba_fwd, dim3(grid), dim3(512), LDS_BYTES, stream, a);
#else
    for (int ph = 0; ph < N_PHASES; ++ph) { a.ph_lo = ph; a.ph_hi = ph + 1; hipLaunchKernelGGL(hymba_fwd, dim3(grid), dim3(512), LDS_BYTES, stream, a); }
#endif
}
```

```cpp
#include <hip/hip_runtime.h>
#include <cstdio>
#include <cstdint>

#define GAS __attribute__((address_space(1)))
#define LAS __attribute__((address_space(3)))
typedef unsigned short bf16;
typedef float f32x4 __attribute__((ext_vector_type(4)));
typedef float f32x2 __attribute__((ext_vector_type(2)));
typedef short bf16x8 __attribute__((ext_vector_type(8)));
typedef unsigned u32x4 __attribute__((ext_vector_type(4)));
typedef unsigned u32x2 __attribute__((ext_vector_type(2)));

constexpr int BATCH = 4, SEQ = 8192, D = 1024, NMETA = 16;
constexpr int LPAD = 8320;
constexpr int PADROWS = 112, REAL0 = 128;
constexpr int MROWS = BATCH * LPAD;
constexpr int NTOK = BATCH * SEQ;
constexpr int INW = 5664, INWP = 5888;
constexpr int C_Z = 0, C_XBC = 1024, C_XS = 1024, C_B = 2048, C_C = 2304, C_DT = 2560, C_Q = 2576, C_K = 3088, C_V = 3600, C_G = 4624, C_ALR = 5648;
constexpr int XBCW = 1536, MIXW = 2048;
constexpr int NEXP = 32, TOPK = 4, DFF = 1024;
constexpr int MAXMT = 544;
constexpr int ACTROWS = MAXMT * 256;
constexpr float EPS = 1e-5f;

constexpr size_t MiB = 1u << 20;
constexpr size_t WS_CTL = 0, CTL_ZERO_BYTES = 1 * MiB;
constexpr size_t WS_WIN = 1 * MiB;
constexpr size_t WS_WOUT = 13 * MiB;
constexpr size_t WS_WGU = 17 * MiB;
constexpr size_t WS_WDN = 145 * MiB;
constexpr size_t WS_R1 = 209 * MiB;
constexpr size_t WS_R2 = 583 * MiB;
constexpr size_t WS_PROJ = WS_R1, WS_ACT = WS_R1;
constexpr size_t WS_MIXRAW = WS_R2;
constexpr size_t WS_SST = WS_R2;
constexpr size_t WS_GST = WS_R2 + 65 * MiB;
constexpr size_t WS_MIXED = WS_R2 + 260 * MiB;
constexpr size_t WS_T = WS_R2;
constexpr size_t WS_YPAIR = WS_R2 + 32 * MiB;
constexpr size_t WS_H1B = WS_R2 + 168 * MiB;
constexpr size_t WS_END = 1024 * MiB;
static_assert(WS_MIXED + (size_t)MROWS * MIXW * 2 <= WS_END && WS_YPAIR + (size_t)ACTROWS * D * 2 <= WS_END && WS_PROJ + (size_t)MROWS * INWP * 2 <= WS_R2, "ws map");
constexpr int CW_CNT = 1024;
constexpr int CW_Q = 2048;
constexpr int CW_BAR = 4096;
constexpr size_t WS_GATES = WS_CTL + 0;
constexpr size_t WS_TAB = WS_R2 + 400 * MiB;
constexpr size_t TAB_GATES = 0, TAB_PE = 512 * 1024, TAB_PS = 1024 * 1024, TAB_LIST = 2 * MiB;
constexpr size_t TAB_CDEC = 6 * MiB, TAB_GDEC = 6 * MiB + 256 * 1024;
static_assert(WS_YPAIR + (size_t)ACTROWS * D <= WS_H1B && WS_H1B + (size_t)NTOK * D * 2 <= WS_MIXED && WS_T + (size_t)NTOK * D <= WS_YPAIR, "h1 map");
static_assert(WS_TAB + 8 * MiB <= WS_END && WS_YPAIR + (size_t)ACTROWS * D * 2 <= WS_TAB && WS_MIXED + (size_t)MROWS * MIXW * 2 <= WS_TAB, "tab map");

constexpr int RING_BYTES = 131072;
constexpr int LDS_BYTES = 147456;
constexpr int MISC_OFF = RING_BYTES;

__host__ __device__ __forceinline__ size_t paddr(long row, int col) {
    const int r = (int)(row & 255), c = col & 255;
    return ((size_t)((row >> 8) * 23 + (col >> 8)) * 131072 + ((((r >> 6) & 1) * 4 + ((c >> 5) & 3)) * 16 + ((r >> 7) * 4 + ((r >> 4) & 3)) * 2 + (c >> 7)) * 1024 + ((c >> 3) & 3) * 256 + (r & 15) * 16 + (c & 7) * 2) >> 1;
}
__host__ __device__ __forceinline__ constexpr int prow16(int k) { return ((k >> 2) * 65536 + (k & 3) * 2048) >> 1; }
__device__ __forceinline__ float bf2f(bf16 b) { return __uint_as_float(((unsigned)b) << 16); }
__device__ __forceinline__ unsigned f2bf(float f) { unsigned u = __float_as_uint(f); return (u + 0x7fffu + ((u >> 16) & 1u)) >> 16; }
typedef __bf16 bf16x2_t __attribute__((ext_vector_type(2)));
__device__ __forceinline__ unsigned pk2(float lo, float hi) { const f32x2 v = {lo, hi}; return __builtin_bit_cast(unsigned, __builtin_convertvector(v, bf16x2_t)); }
__device__ __forceinline__ unsigned pk4_fp8(float a, float b, float c, float d) { unsigned w = 0; w = __builtin_amdgcn_cvt_pk_fp8_f32(a, b, w, false); w = __builtin_amdgcn_cvt_pk_fp8_f32(c, d, w, true); return w; }
constexpr float W8_SCALE = 64.f;
constexpr float SWI_C = 2.45546696f;
constexpr int SCALE_HALF = 0x7C7C7C7C;
__device__ __forceinline__ float wave_sum(float v) {
#pragma unroll
    for (int o = 1; o < 64; o <<= 1) v += __shfl_xor(v, o);
    return v;
}
__device__ __forceinline__ float wave_max(float v) {
#pragma unroll
    for (int o = 1; o < 64; o <<= 1) v = fmaxf(v, __shfl_xor(v, o));
    return v;
}
__device__ __forceinline__ float silu_f(float x) { return x * __builtin_amdgcn_rcpf(1.f + __expf(-x)); }
__device__ __forceinline__ float softplus_f(float x) { return fmaxf(x, 0.f) + __logf(1.f + __expf(-fabsf(x))); }
__device__ __forceinline__ float logsigmoid_f(float x) { return fminf(x, 0.f) - __logf(1.f + __expf(-fabsf(x))); }


typedef GAS unsigned gu32;
#define XB_TMO      128
#define XB_XCNT(j)  (256  + 64 * (j))
#define XB_XSUB(j)  (1280 + 64 * (j))
#define XB_XGEN(j)  (2304 + 64 * (j))
#define XB_TOP      3328
#define XB_TOPGEN   3392
#define XCD_BAR_WORDS 3456
#define XB_SPIN_CAP (1u << 18)
__device__ __forceinline__ unsigned xb_ld(unsigned* p)              { return __hip_atomic_load(p, __ATOMIC_RELAXED, __HIP_MEMORY_SCOPE_AGENT); }
__device__ __forceinline__ unsigned xb_add(unsigned* p, unsigned v) { return __hip_atomic_fetch_add(p, v, __ATOMIC_RELAXED, __HIP_MEMORY_SCOPE_AGENT); }
__device__ __forceinline__ unsigned xb_xcc_id() { return (unsigned)__builtin_amdgcn_s_getreg((3 << 11) | 20) & 0xFu; }
#define XB_SPIN(cond, bar) do { unsigned _sp = 0; while (cond) { __builtin_amdgcn_s_sleep(1); \
    if ((++_sp & 255u) == 0u) { if (xb_ld(&(bar)[XB_TMO])) break; if (_sp > XB_SPIN_CAP) { atomicAdd(&(bar)[XB_TMO], 1u); break; } } } } while (0)
struct XcdBarrier { unsigned* bar; unsigned x; volatile LAS unsigned* st; };
__device__ __forceinline__ XcdBarrier xcd_barrier_post(unsigned* bar, volatile LAS unsigned* st) {
    XcdBarrier b; b.bar = bar; b.x = xb_xcc_id(); b.st = st;
    if (threadIdx.x == 0) (void)xb_add(&bar[XB_XCNT(b.x)], 1u);
    return b;
}
__device__ __forceinline__ void xcd_barrier_complete(unsigned* bar, unsigned x, unsigned& nloc, unsigned& nx) {
    const unsigned G = gridDim.x * gridDim.y * gridDim.z;
    unsigned sum, cnt, mine, sp = 0u;
    for (;;) {
        sum = 0u; cnt = 0u; mine = 0u;
#pragma unroll
        for (unsigned j = 0; j < 16; ++j) { const unsigned c = xb_ld(&bar[XB_XCNT(j)]); sum += c; cnt += (c > 0u) ? 1u : 0u; mine = (j == x) ? c : mine; }
        if (sum == G) break;
        __builtin_amdgcn_s_sleep(1);
        if ((++sp & 255u) == 0u) { if (xb_ld(&bar[XB_TMO])) break; if (sp > XB_SPIN_CAP) { atomicAdd(&bar[XB_TMO], 1u); break; } }
    }
    nloc = mine > 0u ? mine : 1u; nx = cnt > 0u ? cnt : 1u;
}
__device__ __forceinline__ void xcd_barrier(const XcdBarrier& b) {
    asm volatile("s_waitcnt vmcnt(0)" ::: "memory");
    __syncthreads();
    if (threadIdx.x == 0) {
        unsigned* bar = b.bar;
        __builtin_amdgcn_s_waitcnt(0);
        unsigned nloc = b.st[0], nx = b.st[1];
        if (nloc == 0u) { xcd_barrier_complete(bar, b.x, nloc, nx); b.st[0] = nloc; b.st[1] = nx; }
        const unsigned old = xb_add(&bar[XB_XSUB(b.x)], 1u);
        const unsigned gen = old / nloc;
        if (old + 1u == (gen + 1u) * nloc) {
            __builtin_amdgcn_fence(__ATOMIC_RELEASE, "agent");
            asm volatile("s_waitcnt vmcnt(0)" ::: "memory");
            const unsigned og = xb_add(&bar[XB_TOP], 1u);
            const unsigned tg = og / nx;
            if (og + 1u == (tg + 1u) * nx) xb_add(&bar[XB_TOPGEN], 1u);
            else XB_SPIN(xb_ld(&bar[XB_TOPGEN]) == tg, bar);
            __builtin_amdgcn_fence(__ATOMIC_ACQUIRE, "agent");
            xb_add(&bar[XB_XGEN(b.x)], 1u);
            asm volatile("s_waitcnt vmcnt(0)" ::: "memory");
        } else {
            XB_SPIN(xb_ld(&bar[XB_XGEN(b.x)]) == gen, bar);
            __builtin_amdgcn_fence(__ATOMIC_ACQUIRE, "agent");
            asm volatile("s_waitcnt vmcnt(0)" ::: "memory");
        }
    }
    __syncthreads();
}

namespace pg8 {
#define PG8_LAS __attribute__((address_space(3)))
typedef unsigned short bf16_t;
typedef int v8i_t __attribute__((ext_vector_type(8)));
typedef int v4i_t __attribute__((ext_vector_type(4)));
constexpr int BM = 256, BK = 64, HALF = 128, HTB = HALF * BK * 2, STAGE_BYTES = 8 * HTB, NXCD = 8;
__host__ __device__ __forceinline__ int lds_byte(int r, int c) { const int st = (r >> 4) * 2 + (c >> 5), rr = r & 15, cc = c & 31, ob = rr * 64 + cc * 2; return st * 1024 + (ob ^ (((ob >> 9) & 1) << 5)); }
__host__ __device__ __forceinline__ void stage_rc(int b, int& R, int& C) { const int st = b / 1024, sb = b % 1024, swz = sb ^ (((sb >> 9) & 1) << 5); R = (st >> 1) * 16 + swz / 64; C = (st & 1) * 32 + (swz % 64) / 2; }
__host__ __device__ __forceinline__ int perm32(int rho) { const int n = rho >> 4, i = rho & 15; return 8 * (i >> 2) + 4 * n + (i & 3); }

struct Unit { const char* A; const char* B; int pm, pn, e; unsigned bias_lds; };

__device__ __forceinline__ bool static_order(int i, int G, int c, int nM, int nN, int WGM, int& pm, int& pn) {
    const int nwg = nM * nN; const long L = (long)i * G + c; if (L >= nwg) return false;
    int wgid = (int)L; { const int q = nwg / NXCD, r = nwg % NXCD, xcd = wgid % NXCD, off = wgid / NXCD; wgid = (xcd < r ? xcd * (q + 1) : r * (q + 1) + (xcd - r) * q) + off; }
    const int nig = WGM * nN, gid = wgid / nig, fm = gid * WGM, gsz = (nM - fm) < WGM ? (nM - fm) : WGM;
    pm = fm + ((wgid % nig) % gsz); pn = (wgid % nig) / gsz; return true;
}

__device__ __forceinline__ void mfma_fp8(f32x4& acc, const v8i_t& w, const v8i_t& a) {
    asm volatile("s_nop 1\n\tv_mfma_scale_f32_16x16x128_f8f6f4 %0, %1, %2, %0, %3, %3 op_sel_hi:[0,0,0]" : "+v"(acc) : "v"(w), "v"(a), "v"(SCALE_HALF));
}
__device__ __forceinline__ unsigned cvt_pk_bf16(float lo, float hi) { unsigned r; asm volatile("v_cvt_pk_bf16_f32 %0, %1, %2" : "=v"(r) : "v"(lo), "v"(hi)); return r; }

#ifndef SIMPLE_GEMM
#define SIMPLE_GEMM 0
#endif
#ifndef RELAX_EPI
#define RELAX_EPI 0
#endif

template <class Epi, class Sched, bool GATHER, bool FP8 = false>
__device__ __forceinline__ void gemm_phase(PG8_LAS unsigned char* lds, const int K, const Sched& S, const Epi& E) {
    const int tid = threadIdx.x, wid = __builtin_amdgcn_readfirstlane(tid >> 6), lane = tid & 63, wr = wid >> 2, wc = wid & 3, fr = lane & 15, fq = lane >> 4;
#if SIMPLE_GEMM
    Unit cur;
    for (int ui = 0; S.next(ui, cur); ++ui) {
        f32x4 acc[2][2][4][2];
#pragma unroll
        for (int a = 0; a < 2; ++a)
#pragma unroll
            for (int b = 0; b < 2; ++b)
#pragma unroll
                for (int m = 0; m < 4; ++m)
#pragma unroll
                    for (int n = 0; n < 2; ++n) acc[a][b][m][n] = (f32x4){0.f, 0.f, 0.f, 0.f};
        for (int ai = 0; ai < 2; ++ai)
            for (int m = 0; m < 4; ++m) {
                unsigned vo[2][2]; S.a_offs(cur, vo, (wr * 64 + m * 16 + fr) * 4  );
                const char* arow = cur.A + vo[ai][0];
                for (int bj = 0; bj < 2; ++bj)
                    for (int n = 0; n < 2; ++n) {
                        const int brl = wc * 32 + (Epi::CMAP == 1 ? perm32(16 * n + fr) : 16 * n + fr);
                        const char* brow = cur.B + (size_t)(bj * HALF + brl) * K * 2;
                        f32x4 c = acc[ai][bj][m][n];
                        for (int k = 0; k < K; k += 32) {
                            const bf16x8 af = *(const bf16x8*)(arow + (size_t)(k + 8 * fq) * 2);
                            const bf16x8 bfv = *(const bf16x8*)(brow + (size_t)(k + 8 * fq) * 2);
                            c = __builtin_amdgcn_mfma_f32_16x16x32_bf16(bfv, af, c, 0, 0, 0);
                        }
                        acc[ai][bj][m][n] = c;
                    }
            }
        E(acc, cur, wr, wc, fr, fq);
    }
    __syncthreads();
#else
    const int nt = K / BK;
    constexpr bool RLX_ON = RELAX_EPI && !GATHER;
    unsigned voffB[Epi::CMAP == 2 ? 2 : 1][2];
#pragma unroll
    for (int i = 0; i < 2; ++i) { int R_, C_; stage_rc(tid * 16 + i * 8192, R_, C_);
        if constexpr (Epi::CMAP == 2) {
#pragma unroll
            for (int h = 0; h < 2; ++h) { const int Rb = 64 * (R_ >> 5) + 16 * ((R_ & 15) >> 2) + 8 * h + 4 * ((R_ >> 4) & 1) + (R_ & 3); voffB[h][i] = (unsigned)(Rb * K + C_) * 2u; } }
        else { const int Rb = Epi::CMAP == 1 ? ((R_ & ~31) + perm32(R_ & 31)) : R_; voffB[0][i] = (unsigned)(Rb * K + C_) * 2u; } }
#define PG8_STB(h, kb, gb) do { if constexpr (Epi::CMAP == 2) PG8_STAGE(PG8_SB(kb, h), (gb), voffB[h][0], voffB[h][1]); else PG8_STAGE(PG8_SB(kb, h), (gb) + (h) * hstep, voffB[0][0], voffB[0][1]); } while (0)
    const size_t kstep = (size_t)(BK * 2);
    const size_t hstep = (size_t)HALF * K * 2;
    const unsigned ldsw = (unsigned)wid * 1024u;
    const int aoff = lds_byte(wr * 64 + fr, fq * 8), boff = lds_byte(wc * 32 + fr, fq * 8);
#define PG8_SA(b, h) (((b) * 2 + (h)) * HTB)
#define PG8_SB(b, h) ((4 + (b) * 2 + (h)) * HTB)
#define PG8_GL(gp, ldsoff) __builtin_amdgcn_global_load_lds((const unsigned*)(gp), (PG8_LAS unsigned*)(lds + (ldsoff)), 16, 0, 0)
#define PG8_STAGE(bufoff, gbase, v0, v1) do { PG8_GL((const char*)(gbase) + (v0), (bufoff) + ldsw); PG8_GL((const char*)(gbase) + (v1), (bufoff) + ldsw + 8192); } while (0)
#define PG8_LD8(off) __builtin_shufflevector(*(const PG8_LAS v4i_t*)(lds + (off)), *(const PG8_LAS v4i_t*)(lds + (off) + 1024), 0, 1, 2, 3, 4, 5, 6, 7)
#define PG8_LDA(dst, b, h) do { if constexpr (FP8) { _Pragma("unroll") for (int m = 0; m < 4; ++m) dst##8[m] = PG8_LD8(PG8_SA(b, h) + aoff + m * 2048); } \
        else { _Pragma("unroll") for (int m = 0; m < 4; ++m) _Pragma("unroll") for (int k = 0; k < 2; ++k) dst[m][k] = *(const PG8_LAS bf16x8*)(lds + PG8_SA(b, h) + aoff + m * 2048 + k * 1024); } } while (0)
#define PG8_LDB(dst, b, h) do { if constexpr (FP8) { _Pragma("unroll") for (int n = 0; n < 2; ++n) dst##8[n] = PG8_LD8(PG8_SB(b, h) + boff + n * 2048); } \
        else { _Pragma("unroll") for (int n = 0; n < 2; ++n) _Pragma("unroll") for (int k = 0; k < 2; ++k) dst[n][k] = *(const PG8_LAS bf16x8*)(lds + PG8_SB(b, h) + boff + n * 2048 + k * 1024); } } while (0)
#define PG8_MMA(ai, bj, At, Bt) do { __builtin_amdgcn_s_setprio(1); \
        if constexpr (FP8) { _Pragma("unroll") for (int m = 0; m < 4; ++m) _Pragma("unroll") for (int n = 0; n < 2; ++n) \
            mfma_fp8(acc[ai][bj][m][n], Bt##8[n], At##8[m]); } \
        else { _Pragma("unroll") for (int m = 0; m < 4; ++m) _Pragma("unroll") for (int n = 0; n < 2; ++n) _Pragma("unroll") for (int k = 0; k < 2; ++k) \
            acc[ai][bj][m][n] = __builtin_amdgcn_mfma_f32_16x16x32_bf16(Bt[n][k], At[m][k], acc[ai][bj][m][n], 0, 0, 0); } \
        __builtin_amdgcn_s_setprio(0); } while (0)
#define PG8_WAIT_V(n) asm volatile("s_waitcnt vmcnt(" #n ")" ::: "memory")
#define PG8_WAIT_L(n) asm volatile("s_waitcnt lgkmcnt(" #n ")" ::: "memory")
#define PG8_BAR __builtin_amdgcn_s_barrier()
#define PG8_SCHED __builtin_amdgcn_sched_barrier(0)
    Unit cur, nxt; int ui = 0;
    if (!S.next(0, cur)) return;
    f32x4 acc[2][2][4][2];
#pragma unroll
    for (int a = 0; a < 2; ++a)
#pragma unroll
        for (int b = 0; b < 2; ++b)
#pragma unroll
            for (int m = 0; m < 4; ++m)
#pragma unroll
                for (int n = 0; n < 2; ++n) acc[a][b][m][n] = (f32x4){0.f, 0.f, 0.f, 0.f};
    bf16x8 At[4][2], B0[2][2], B1[2][2];
    v8i_t At8[4], B08[2], B18[2];
    unsigned vAc[2][2], vAn[2][2];
    S.a_offs(cur, vAc, tid);
    const char* cA = cur.A; const char* cB = cur.B;
#define PG8_BIAS_DMA(u, par) do { if constexpr (Epi::LDS_BIAS) { (u).bias_lds = (unsigned)(STAGE_BYTES + 2048 + (par) * 1024); \
        if (wid == 0) { int bl_ = lane; asm volatile("" : "+v"(bl_)); __builtin_amdgcn_global_load_lds((const unsigned*)S.bias_src((u), bl_), (PG8_LAS unsigned*)(lds + STAGE_BYTES + 2048 + (par) * 1024), 16, 0, 0); } } } while (0)
    PG8_BIAS_DMA(cur, 0);
    if constexpr (Epi::BIAS_INIT) {
        PG8_WAIT_V(0); PG8_BAR; int et = threadIdx.x; asm volatile("" : "+v"(et)); E.init(acc, cur, wc, (et >> 4) & 3); }
    PG8_STB(0, 0, cB); PG8_STB(1, 0, cB); PG8_STAGE(PG8_SA(0, 0), cA, vAc[0][0], vAc[0][1]); PG8_STAGE(PG8_SA(0, 1), cA, vAc[1][0], vAc[1][1]);
    if (wr == 1) PG8_BAR;
    PG8_WAIT_V(2); PG8_BAR;
    PG8_STB(0, 1, cB + kstep); PG8_STAGE(PG8_SA(1, 0), cA + kstep, vAc[0][0], vAc[0][1]); PG8_STB(1, 1, cB + kstep);
    PG8_WAIT_V(6); PG8_BAR;
    for (;;) {
        const bool has_next = S.next(ui + 1, nxt);
        const char* nA = has_next ? nxt.A : cA; const char* nB = has_next ? nxt.B : cB;
        if constexpr (Epi::BIAS_INIT) { if (has_next) PG8_BIAS_DMA(nxt, (ui + 1) & 1); }
        if constexpr (GATHER) {
            if (has_next) S.a_offs(nxt, vAn, tid);
            else { vAn[0][0] = vAc[0][0]; vAn[0][1] = vAc[0][1]; vAn[1][0] = vAc[1][0]; vAn[1][1] = vAc[1][1]; }
        }
#define PG8_KITER(RLX) do { \
            const bool last = (t == nt - 2); \
            const char* a1 = cA + (size_t)(t + 1) * kstep; \
            const char* a2 = last ? nA : cA + (size_t)(t + 2) * kstep; const char* b2 = last ? nB : cB + (size_t)(t + 2) * kstep; \
            const char* a3 = a2 + kstep; const char* b3 = b2 + kstep; \
            unsigned o00 = vAc[0][0], o01 = vAc[0][1], o10 = vAc[1][0], o11 = vAc[1][1]; \
            if constexpr (GATHER) { if (last) { o00 = vAn[0][0]; o01 = vAn[0][1]; o10 = vAn[1][0]; o11 = vAn[1][1]; } } \
              \
            PG8_LDB(B0, 0, 0); PG8_LDB(B1, 0, 1); PG8_SCHED; PG8_LDA(At, 0, 0); if (!(RLX)) PG8_STAGE(PG8_SA(1, 1), a1, vAc[1][0], vAc[1][1]); \
            PG8_WAIT_VN((RLX) ? 8 + Epi::NST : 8); PG8_WAIT_L(0); PG8_BAR; PG8_MMA(0, 0, At, B0); PG8_MMA(0, 1, At, B1); PG8_BAR; PG8_SCHED; \
              \
            PG8_LDA(At, 0, 1); PG8_STB(0, 0, b2); PG8_STB(1, 0, b2); PG8_STAGE(PG8_SA(0, 0), a2, o00, o01); \
            PG8_WAIT_VN((RLX) ? 8 + Epi::NST : 8); PG8_WAIT_L(0); PG8_BAR; PG8_MMA(1, 0, At, B0); PG8_MMA(1, 1, At, B1); PG8_BAR; PG8_SCHED; \
              \
            PG8_LDB(B0, 1, 0); PG8_LDB(B1, 1, 1); PG8_SCHED; PG8_LDA(At, 1, 0); PG8_STAGE(PG8_SA(0, 1), a2, o10, o11); \
            PG8_WAIT_VN((RLX) ? 8 + Epi::NST : 8); PG8_WAIT_L(0); PG8_BAR; PG8_MMA(0, 0, At, B0); PG8_MMA(0, 1, At, B1); PG8_BAR; PG8_SCHED; \
              \
            PG8_LDA(At, 1, 1); PG8_STB(0, 1, b3); PG8_STB(1, 1, b3); PG8_STAGE(PG8_SA(1, 0), a3, o00, o01); \
            PG8_WAIT_VN(8); PG8_WAIT_L(0); PG8_BAR; PG8_MMA(1, 0, At, B0); \
            if constexpr (Epi::SPLIT) { if (last) { PG8_SCHED; if constexpr (FP8) asm volatile("s_nop 15\n\ts_nop 15" ::: "memory"); int et = threadIdx.x; asm volatile("" : "+v"(et)); E.template part<0, 1>(acc, cur, wr, wc, et & 15, (et >> 4) & 3); PG8_SCHED; } } \
            PG8_MMA(1, 1, At, B1); PG8_BAR; PG8_SCHED; \
        } while (0)
#define PG8_WAIT_VN(n) asm volatile("s_waitcnt vmcnt(%0)" :: "n"(n) : "memory")
        int t = 0;
        if (RLX_ON && ui > 0) { PG8_KITER(true); t = 2; }
        for (; t < nt; t += 2) PG8_KITER(false);
#undef PG8_KITER
#undef PG8_WAIT_VN
        if (RLX_ON && has_next) {
            if constexpr (GATHER) PG8_STAGE(PG8_SA(1, 1), nA + kstep, vAn[1][0], vAn[1][1]); else PG8_STAGE(PG8_SA(1, 1), nA + kstep, vAc[1][0], vAc[1][1]);
        }
        if constexpr (FP8) asm volatile("s_nop 15\n\ts_nop 15" ::: "memory");
        if (wr == 0) PG8_BAR;
        { int et = threadIdx.x; asm volatile("" : "+v"(et)); if constexpr (Epi::SPLIT) E.template part<1, 2>(acc, cur, wr, wc, et & 15, (et >> 4) & 3); else E(acc, cur, wr, wc, et & 15, (et >> 4) & 3); }
        if (!has_next) break;
        if constexpr (Epi::BIAS_INIT) { int et = threadIdx.x; asm volatile("" : "+v"(et)); E.init(acc, nxt, wc, (et >> 4) & 3); }
        else {
#pragma unroll
        for (int a = 0; a < 2; ++a)
#pragma unroll
            for (int b = 0; b < 2; ++b)
#pragma unroll
                for (int m = 0; m < 4; ++m)
#pragma unroll
                    for (int n = 0; n < 2; ++n) { acc[a][b][m][n] = (f32x4){0.f, 0.f, 0.f, 0.f}; asm volatile("" : "+v"(acc[a][b][m][n])); }
        }
        cur = nxt; cA = nA; cB = nB; ++ui;
        if constexpr (!Epi::BIAS_INIT) PG8_BIAS_DMA(cur, ui & 1);
        if constexpr (GATHER) { vAc[0][0] = vAn[0][0]; vAc[0][1] = vAn[0][1]; vAc[1][0] = vAn[1][0]; vAc[1][1] = vAn[1][1]; }
        if (wr == 1) PG8_BAR;
    }
    PG8_WAIT_V(0);
    PG8_BAR;
#undef PG8_BIAS_DMA
#undef PG8_STB
#undef PG8_SA
#undef PG8_SB
#undef PG8_GL
#undef PG8_STAGE
#undef PG8_LDA
#undef PG8_LD8
#undef PG8_LDB
#undef PG8_MMA
#undef PG8_WAIT_V
#undef PG8_WAIT_L
#undef PG8_BAR
#undef PG8_SCHED
#endif
}
}

struct Args { const float* in[22]; float* out; unsigned char* ws; int ph_lo, ph_hi; };
struct Frame {
    LAS unsigned char* lds; unsigned char* ws; int tid, lane, wave, G, bid;
    const float *x, *meta, *mix_norm_w, *w_in, *conv_w, *conv_b, *dt_bias, *a_log, *d_skip, *ssd_norm_w, *w_decay_up, *b_decay, *gla_norm_w, *w_out, *ffn_norm_w, *w_router, *b_router, *w_gate_up, *b_gate_up, *w_down, *b_down, *final_norm_w;
    float* out;
};

__device__ __forceinline__ void transpose_item(const float* W, int K, int N, bf16* WT, int mode, LAS float* scr, int item, int lane) {
    const int nblk = N / 32, kb = item / nblk, nb = item % nblk, k0 = 64 * kb, n0 = 32 * nb;
#pragma unroll 8
    for (int i = 0; i < 32; ++i) { const int kk = 2 * i + (lane >> 5); scr[kk * 33 + (lane & 31)] = W[(size_t)(k0 + kk) * N + n0 + (lane & 31)]; }
    asm volatile("s_waitcnt lgkmcnt(0)" ::: "memory");
    int rbase = n0;
    if (mode == 1) { const int f0 = n0 & 1023; rbase = 256 * (f0 >> 7) + (f0 & 127) + ((n0 >= 1024) ? 128 : 0); }
    const int c = lane & 7;
#pragma unroll
    for (int j = 0; j < 4; ++j) { const int n = (lane >> 3) + 8 * j; const LAS float* s = scr + (8 * c) * 33 + n;
        u32x4 o; o.x = pk2(s[0 * 33], s[1 * 33]); o.y = pk2(s[2 * 33], s[3 * 33]); o.z = pk2(s[4 * 33], s[5 * 33]); o.w = pk2(s[6 * 33], s[7 * 33]);
        *(u32x4*)(WT + (size_t)(rbase + n) * K + k0 + 8 * c) = o; }
    asm volatile("s_waitcnt lgkmcnt(0)" ::: "memory");
}
__device__ __forceinline__ void item8_load(const float* W, int N, int item, int lane, float (&r)[32]) {
    const int nblk = N / 32, kb = item / nblk, nb = item % nblk, k0 = 64 * kb, n0 = 32 * nb;
#pragma unroll
    for (int i = 0; i < 32; ++i) { const int kk = 2 * i + (lane >> 5); r[i] = __builtin_nontemporal_load(W + (size_t)(k0 + kk) * N + n0 + (lane & 31));     }
}
__device__ __forceinline__ void item8_finish(const float (&r)[32], int K, int N, unsigned char* WT, int mode, LAS float* scr, int item, int lane) {
    const int nblk = N / 32, kb = item / nblk, nb = item % nblk, k0 = 64 * kb, n0 = 32 * nb;
#pragma unroll
    for (int i = 0; i < 32; ++i) { const int kk = 2 * i + (lane >> 5); scr[kk * 33 + (lane & 31)] = r[i]; }
    asm volatile("s_waitcnt lgkmcnt(0)" ::: "memory");
    int rbase = n0;
    if (mode == 1) { const int f0 = n0 & 1023; rbase = 256 * (f0 >> 7) + (f0 & 127) + ((n0 >= 1024) ? 128 : 0); }
    const int c = lane & 7;
    const float sc = mode == 1 ? (n0 >= 1024 ? W8_SCALE / SWI_C : W8_SCALE * SWI_C) : W8_SCALE;
#pragma unroll
    for (int j = 0; j < 4; ++j) { const int n = (lane >> 3) + 8 * j; const LAS float* s = scr + (8 * c) * 33 + n;
        u32x2 o; o.x = pk4_fp8(s[0 * 33] * sc, s[1 * 33] * sc, s[2 * 33] * sc, s[3 * 33] * sc); o.y = pk4_fp8(s[4 * 33] * sc, s[5 * 33] * sc, s[6 * 33] * sc, s[7 * 33] * sc);
        __builtin_nontemporal_store(o, (u32x2*)(WT + (size_t)(rbase + n) * K + k0 + 8 * c));     }
    asm volatile("s_waitcnt lgkmcnt(0)" ::: "memory");
}
constexpr int I_GU = (D / 64) * (2 * DFF / 32), I_DN = (DFF / 64) * (D / 32), N_MOE_ITEMS = NEXP * (I_GU + I_DN);
__device__ __forceinline__ void moe_item_addr(Frame& F, int it, const float*& W, int& K, int& N, unsigned char*& WT, int& mode, int& sub) {
    if (it < NEXP * I_GU) { const int e = it / I_GU; W = F.w_gate_up + (size_t)e * D * 2 * DFF; K = D; N = 2 * DFF; WT = F.ws + WS_WGU + (size_t)e * 2 * DFF * D; mode = 1; sub = it % I_GU; }
    else { const int r = it - NEXP * I_GU, e = r / I_DN; W = F.w_down + (size_t)e * DFF * D; K = DFF; N = D; WT = F.ws + WS_WDN + (size_t)e * D * DFF; mode = 0; sub = r % I_DN; }
}
__device__ __forceinline__ void convert_moe_weights(Frame& F) {
    volatile LAS int* slot = (volatile LAS int*)(F.lds + LDS_BYTES - 32);
    LAS float* scr = (LAS float*)(F.lds + F.wave * 16384);
    unsigned* head = (unsigned*)(F.ws + WS_CTL) + CW_Q + 128;
    for (;;) {
        __syncthreads();
        if (F.tid == 0) *slot = (int)__hip_atomic_fetch_add(head, 64u, __ATOMIC_RELAXED, __HIP_MEMORY_SCOPE_AGENT);
        __syncthreads();
        const int base = *slot;
        if (base >= N_MOE_ITEMS) break;
        const int it0 = base + F.wave * 8;
        float ra[32], rb[32]; const float* W; int K, N, mode, sub; unsigned char* WT;
        moe_item_addr(F, it0, W, K, N, WT, mode, sub); item8_load(W, N, sub, F.lane, ra);
#pragma unroll 1
        for (int q = 0; q < 8; q += 2) {
            const float* W1; int K1, N1, mode1, sub1; unsigned char* WT1;
            moe_item_addr(F, it0 + q + 1, W1, K1, N1, WT1, mode1, sub1); item8_load(W1, N1, sub1, F.lane, rb);
            item8_finish(ra, K, N, WT, mode, scr, sub, F.lane);
            if (q + 2 < 8) { moe_item_addr(F, it0 + q + 2, W, K, N, WT, mode, sub); item8_load(W, N, sub, F.lane, ra); }
            item8_finish(rb, K1, N1, WT1, mode1, scr, sub1, F.lane);
        }
    }
    __syncthreads();
}
__device__ __forceinline__ void phase_prep(Frame& F) {
    LAS float* scr = (LAS float*)(F.lds + F.wave * 16384);
    const int gw = F.bid * 8 + F.wave, NGW = F.G * 8;
    constexpr int I_IN = (D / 64) * (INW / 32), I_OUT = (MIXW / 64) * (D / 32);
    constexpr int NITEMS = I_IN + I_OUT;
    bf16* win = (bf16*)(F.ws + WS_WIN);
    for (int it = gw; it < NITEMS; it += NGW) {
        int r = it;
        if (r < I_IN) { transpose_item(F.w_in, D, INW, win, 0, scr, r, F.lane); continue; } r -= I_IN;
        { float rr[32]; item8_load(F.w_out, D, r, F.lane, rr); item8_finish(rr, MIXW, D, F.ws + WS_WOUT, 0, scr, r, F.lane); }
    }
    { u32x4* z = (u32x4*)(win + (size_t)INW * D); const int n16 = (INWP - INW) * D * 2 / 16;
      for (int i = F.bid * 512 + F.tid; i < n16; i += F.G * 512) z[i] = (u32x4){0u, 0u, 0u, 0u}; }
    bf16* U = (bf16*)F.out;
    for (int r = gw; r < MROWS; r += NGW) {
        const int b = r / LPAD, p = r % LPAD;
        unsigned long long* o8 = (unsigned long long*)(U + (size_t)r * D) + F.lane;
        if (p < PADROWS) {
#pragma unroll
            for (int j = 0; j < 4; ++j) o8[64 * j] = 0ull;
            continue; }
        const float* src = (p < REAL0) ? F.meta + (size_t)(p - PADROWS) * D : F.x + ((size_t)b * SEQ + (p - REAL0)) * D;
        const f32x4* xr = (const f32x4*)src + F.lane; const f32x4* wr_ = (const f32x4*)F.mix_norm_w + F.lane;
        f32x4 v[4]; float s = 0.f;
#pragma unroll
        for (int j = 0; j < 4; ++j) { v[j] = __builtin_nontemporal_load(xr + 64 * j); s += (v[j].x * v[j].x + v[j].y * v[j].y) + (v[j].z * v[j].z + v[j].w * v[j].w); }
        const float rstd = rsqrtf(wave_sum(s) * (1.f / D) + EPS);
#pragma unroll
        for (int j = 0; j < 4; ++j) { const f32x4 w = wr_[64 * j]; o8[64 * j] = (unsigned long long)pk2(v[j].x * rstd * w.x, v[j].y * rstd * w.y) | ((unsigned long long)pk2(v[j].z * rstd * w.z, v[j].w * rstd * w.w) << 32); }
    }
}

#ifndef WGM_IN
#define WGM_IN 4
#endif
#ifndef WGM_OUT
#define WGM_OUT 4
#endif
#ifndef WGM_GU
#define WGM_GU 4
#endif
#ifndef WGM_DN
#define WGM_DN 4
#endif
#ifndef SPLIT_GU
#define SPLIT_GU false
#endif
#ifndef SPLIT_DN
#define SPLIT_DN false
#endif
#ifndef NT_EPI
#define NT_EPI 0
#endif
#if NT_EPI
#define EPI_ST(p, v) __builtin_nontemporal_store((v), (p))
#else
#define EPI_ST(p, v) (*(p) = (v))
#endif
struct SchedDense {
    const char* A; const char* Bt; int K, nM, nN, G, c; bool remap; int wgm;
    __device__ __forceinline__ const float* bias_src(const pg8::Unit&, int) const { return nullptr; }
    __device__ __forceinline__ bool next(int i, pg8::Unit& u) const {
        int pm, pn; if (!pg8::static_order(i, G, c, nM, nN, wgm, pm, pn)) return false;
        u.pm = pm; u.pn = pn; u.e = 0;
        size_t arow = (size_t)pm * 256; if (remap) { const int b = (pm * 256) / SEQ, t = (pm * 256) % SEQ; arow = (size_t)b * LPAD + REAL0 + t; }
        u.A = A + arow * K * 2; u.B = Bt + (size_t)pn * 256 * K * 2; return true;
    }
    __device__ __forceinline__ void a_offs(const pg8::Unit&, unsigned (&vo)[2][2], int tid) const {
#pragma unroll
        for (int i = 0; i < 2; ++i) { int R, C; pg8::stage_rc(tid * 16 + i * 8192, R, C);
#pragma unroll
            for (int h = 0; h < 2; ++h) vo[h][i] = (unsigned)((h * 128 + R) * K + C) * 2u; }
    }
};
struct SchedMoe {
    const char* A; const char* Bt; int K, nN, G, c; bool gather; size_t bexp; int wgm;
    const int* list; const LAS int* tstart; const LAS int* cnt; const float* bias;
    __device__ __forceinline__ const float* bias_src(const pg8::Unit& u, int lane) const {
        return gather ? bias + (size_t)u.e * 2 * DFF + (lane >> 5) * DFF + u.pn * 128 + 4 * (lane & 31) : bias + (size_t)u.e * D + u.pn * 256 + 4 * lane; }
    __device__ __forceinline__ bool next(int i, pg8::Unit& u) const {
        const int nM = tstart[NEXP]; int pm, pn; if (!pg8::static_order(i, G, c, nM, nN, wgm, pm, pn)) return false;
        if (!gather) pm = nM - 1 - pm;
        int tl = threadIdx.x; asm volatile("" : "+v"(tl)); tl &= 63;
        const int e = __popcll(__ballot(tl >= 1 && tl < NEXP && tstart[tl & 31] <= pm));
        u.pm = pm; u.pn = pn; u.e = e;
        u.A = gather ? A : A + (size_t)pm * 256 * K * 2; u.B = Bt + (size_t)e * bexp + (size_t)pn * 256 * K * 2; return true;
    }
    __device__ __forceinline__ void a_offs(const pg8::Unit& u, unsigned (&vo)[2][2], int tid) const {
        asm volatile("" : "+v"(tid));
        const int e = u.e, r0 = (u.pm - tstart[e]) * 256, n1 = cnt[e] - 1;
#pragma unroll
        for (int i = 0; i < 2; ++i) { int R, C; pg8::stage_rc(tid * 16 + i * 8192, R, C);
#pragma unroll
            for (int h = 0; h < 2; ++h) {
                if (gather) { const int rr = min(r0 + h * 128 + R, n1); const int tok = list[e * NTOK + rr]; vo[h][i] = (unsigned)(tok * K + C) * 2u; }
                else vo[h][i] = (unsigned)((h * 128 + R) * K + C) * 2u; } }
    }
};
template <bool LB, bool TILED = false> struct EpiBf16T {
    static constexpr int CMAP = 1;
    static constexpr int NST = 16;
    static constexpr bool BIAS_INIT = false;
    static constexpr bool LDS_BIAS = LB;
    bf16* O; int ldc; LAS unsigned char* lds;
    static constexpr bool SPLIT = !LB;
    __device__ __forceinline__ void operator()(const f32x4 (&acc)[2][2][4][2], const pg8::Unit& u, int wr, int wc, int fr, int fq) const { part<0, 2>(acc, u, wr, wc, fr, fq); }
    template <int AI0, int AI1> __device__ __forceinline__ void part(const f32x4 (&acc)[2][2][4][2], const pg8::Unit& u, int wr, int wc, int fr, int fq) const {
        const int row0 = u.pm * 256 + wr * 64 + fr, col0 = u.pn * 256 + wc * 32 + 8 * fq;
        f32x4 bv[2][2];
#pragma unroll
        for (int bj = 0; bj < 2; ++bj)
#pragma unroll
            for (int n = 0; n < 2; ++n) bv[bj][n] = LB ? *(const LAS f32x4*)(lds + u.bias_lds + (wc * 32 + 8 * fq + bj * 128 + 4 * n) * 4) : (f32x4){0.f, 0.f, 0.f, 0.f};
#pragma unroll
        for (int ai = AI0; ai < AI1; ++ai)
#pragma unroll
            for (int m = 0; m < 4; ++m) { bf16* rowp = O + (size_t)(row0 + ai * 128 + m * 16) * ldc + col0;
#pragma unroll
                for (int bj = 0; bj < 2; ++bj) { f32x4 v0 = acc[ai][bj][m][0], v1 = acc[ai][bj][m][1]; if (LB) { v0 = v0 + bv[bj][0]; v1 = v1 + bv[bj][1]; }
                    u32x4 w; w.x = pg8::cvt_pk_bf16(v0[0], v0[1]); w.y = pg8::cvt_pk_bf16(v0[2], v0[3]); w.z = pg8::cvt_pk_bf16(v1[0], v1[1]); w.w = pg8::cvt_pk_bf16(v1[2], v1[3]);
                    if (TILED) EPI_ST((u32x4*)((unsigned char*)O + (size_t)(u.pm * 23 + u.pn) * 131072 + ((wr * 4 + wc) * 16 + (ai * 4 + m) * 2 + bj) * 1024 + (fq * 16 + fr) * 16), w);
                    else EPI_ST((u32x4*)(rowp + bj * 128), w); } }
    }
};
typedef EpiBf16T<false> EpiBf16; typedef EpiBf16T<true> EpiBf16B; typedef EpiBf16T<false, true> EpiProj;
struct EpiFp8Row {
    static constexpr int CMAP = 2; static constexpr int NST = 8; static constexpr bool LDS_BIAS = true; static constexpr bool BIAS_INIT = true; static constexpr bool SPLIT = SPLIT_DN;
    unsigned char* O; int ldc; LAS unsigned char* lds;
    __device__ __forceinline__ void init(f32x4 (&acc)[2][2][4][2], const pg8::Unit& u, int wc, int fq) const {
#pragma unroll
        for (int bj = 0; bj < 2; ++bj)
#pragma unroll
            for (int n = 0; n < 2; ++n) { const f32x4 bv = *(const LAS f32x4*)(lds + u.bias_lds + (wc * 64 + 16 * fq + 8 * bj + 4 * n) * 4);
#pragma unroll
                for (int ai = 0; ai < 2; ++ai)
#pragma unroll
                    for (int m = 0; m < 4; ++m) acc[ai][bj][m][n] = bv; }
    }
    __device__ __forceinline__ void operator()(const f32x4 (&acc)[2][2][4][2], const pg8::Unit& u, int wr, int wc, int fr, int fq) const { part<0, 2>(acc, u, wr, wc, fr, fq); }
    template <int AI0, int AI1> __device__ __forceinline__ void part(const f32x4 (&acc)[2][2][4][2], const pg8::Unit& u, int wr, int wc, int fr, int fq) const {
        const int row0 = u.pm * 256 + wr * 64 + fr, colt = wc * 64 + 16 * fq;
#pragma unroll
        for (int ai = AI0; ai < AI1; ++ai)
#pragma unroll
            for (int m = 0; m < 4; ++m) { unsigned char* rowp = O + (size_t)(row0 + ai * 128 + m * 16) * ldc + u.pn * 256 + colt;
                const f32x4 v00 = acc[ai][0][m][0], v01 = acc[ai][0][m][1], v10 = acc[ai][1][m][0], v11 = acc[ai][1][m][1];
                EPI_ST((u32x4*)rowp, ((u32x4){pk4_fp8(v00[0], v00[1], v00[2], v00[3]), pk4_fp8(v01[0], v01[1], v01[2], v01[3]), pk4_fp8(v10[0], v10[1], v10[2], v10[3]), pk4_fp8(v11[0], v11[1], v11[2], v11[3])})); }
    }
};
struct EpiResidF32 {
    static constexpr int CMAP = 0; static constexpr int NST = 32; static constexpr bool LDS_BIAS = false; static constexpr bool BIAS_INIT = false; static constexpr bool SPLIT = true;
    const float* resid; float* out;
    __device__ __forceinline__ void operator()(const f32x4 (&acc)[2][2][4][2], const pg8::Unit& u, int wr, int wc, int fr, int fq) const { part<0, 2>(acc, u, wr, wc, fr, fq); }
    template <int AI0, int AI1> __device__ __forceinline__ void part(const f32x4 (&acc)[2][2][4][2], const pg8::Unit& u, int wr, int wc, int fr, int fq) const {
        const int row0 = u.pm * 256 + wr * 64 + fr, col0 = u.pn * 256 + wc * 32 + 4 * fq;
#pragma unroll
        for (int ai = AI0; ai < AI1; ++ai)
#pragma unroll
            for (int m = 0; m < 4; ++m) { const size_t off = (size_t)(row0 + ai * 128 + m * 16) * D + col0;
#pragma unroll
                for (int bj = 0; bj < 2; ++bj)
#pragma unroll
                    for (int n = 0; n < 2; ++n) { const f32x4 r = *(const f32x4*)(resid + off + bj * 128 + n * 16); *(f32x4*)(out + off + bj * 128 + n * 16) = r + acc[ai][bj][m][n]; } }
    }
};
struct EpiResidBf16 {
    static constexpr int CMAP = 1; static constexpr int NST = 16; static constexpr bool LDS_BIAS = false; static constexpr bool BIAS_INIT = false; static constexpr bool SPLIT = false;
    const float* resid; bf16* out;
    __device__ __forceinline__ void operator()(const f32x4 (&acc)[2][2][4][2], const pg8::Unit& u, int wr, int wc, int fr, int fq) const {
        const int row0 = u.pm * 256 + wr * 64 + fr, col0 = u.pn * 256 + wc * 32 + 8 * fq;
#pragma unroll
        for (int ai = 0; ai < 2; ++ai) { f32x4 r[4][2][2];
#pragma unroll
            for (int m = 0; m < 4; ++m) { const float* rp = resid + (size_t)(row0 + ai * 128 + m * 16) * D + col0;
#pragma unroll
                for (int bj = 0; bj < 2; ++bj) { r[m][bj][0] = __builtin_nontemporal_load((const f32x4*)(rp + bj * 128)); r[m][bj][1] = __builtin_nontemporal_load((const f32x4*)(rp + bj * 128 + 4)); } }
            asm volatile("" ::: "memory");
#pragma unroll
            for (int m = 0; m < 4; ++m) { bf16* op = out + (size_t)(row0 + ai * 128 + m * 16) * D + col0;
#pragma unroll
                for (int bj = 0; bj < 2; ++bj) { const f32x4 v0 = r[m][bj][0] + acc[ai][bj][m][0], v1 = r[m][bj][1] + acc[ai][bj][m][1];
                    u32x4 w; w.x = pg8::cvt_pk_bf16(v0[0], v0[1]); w.y = pg8::cvt_pk_bf16(v0[2], v0[3]); w.z = pg8::cvt_pk_bf16(v1[0], v1[1]); w.w = pg8::cvt_pk_bf16(v1[2], v1[3]);
                    *(u32x4*)(op + bj * 128) = w; } }
            asm volatile("" ::: "memory"); }
    }
    template <int AI0, int AI1> __device__ __forceinline__ void part(const f32x4 (&acc)[2][2][4][2], const pg8::Unit& u, int wr, int wc, int fr, int fq) const { (*this)(acc, u, wr, wc, fr, fq); }
};
struct EpiSwiglu {
    static constexpr int CMAP = 1; static constexpr int NST = 8; static constexpr bool LDS_BIAS = true; static constexpr bool BIAS_INIT = true; static constexpr bool SPLIT = SPLIT_GU;
    bf16* O; LAS unsigned char* lds;
    __device__ __forceinline__ void init(f32x4 (&acc)[2][2][4][2], const pg8::Unit& u, int wc, int fq) const {
#pragma unroll
        for (int n = 0; n < 2; ++n) { f32x4 bg = *(const LAS f32x4*)(lds + u.bias_lds + (wc * 32 + 8 * fq + 4 * n) * 4); f32x4 bu = *(const LAS f32x4*)(lds + u.bias_lds + (128 + wc * 32 + 8 * fq + 4 * n) * 4);
            bg = bg * SWI_C; bu = (bu + (f32x4){1.f, 1.f, 1.f, 1.f}) * (1.f / SWI_C);
#pragma unroll
            for (int ai = 0; ai < 2; ++ai)
#pragma unroll
                for (int m = 0; m < 4; ++m) { acc[ai][0][m][n] = bg; acc[ai][1][m][n] = bu; } }
    }
    __device__ __forceinline__ void operator()(const f32x4 (&acc)[2][2][4][2], const pg8::Unit& u, int wr, int wc, int fr, int fq) const { part<0, 2>(acc, u, wr, wc, fr, fq); }
    template <int AI0, int AI1> __device__ __forceinline__ void part(const f32x4 (&acc)[2][2][4][2], const pg8::Unit& u, int wr, int wc, int fr, int fq) const {
        const int row0 = u.pm * 256 + wr * 64 + fr, f0 = u.pn * 128 + wc * 32 + 8 * fq;
#pragma unroll
        for (int ai = AI0; ai < AI1; ++ai)
#pragma unroll
            for (int m = 0; m < 4; ++m) { unsigned char* rowp = (unsigned char*)O + (size_t)(row0 + ai * 128 + m * 16) * DFF + f0;
                float o[8];
#pragma unroll
                for (int n = 0; n < 2; ++n)
#pragma unroll
                    for (int i = 0; i < 4; ++i) { float G = acc[ai][0][m][n][i], U = acc[ai][1][m][n][i];
                        G = fminf(G, 7.f * SWI_C); U = fminf(fmaxf(U, -6.f / SWI_C), 8.f / SWI_C);
                        o[4 * n + i] = U * (G * __builtin_amdgcn_rcpf(1.f + __builtin_amdgcn_exp2f(-G))); }
                EPI_ST((u32x2*)rowp, ((u32x2){pk4_fp8(o[0], o[1], o[2], o[3]), pk4_fp8(o[4], o[5], o[6], o[7])})); }
    }
};

__device__ __forceinline__ void phase_inproj(Frame& F, bool conv) {
    const int G1 = (conv && F.G >= 64) ? F.G - (F.G * 5) / 32 : F.G;
    if (F.bid < G1) {
        SchedDense S{(const char*)F.out, (const char*)(F.ws + WS_WIN), D, MROWS / 256, INWP / 256, G1, F.bid, false, WGM_IN};
        EpiProj E{(bf16*)(F.ws + WS_PROJ), INWP, F.lds};
        pg8::gemm_phase<EpiProj, SchedDense, false>(F.lds, D, S, E);
    }
    if (conv) convert_moe_weights(F);
}
__device__ __forceinline__ void phase_outproj(Frame& F) {
    SchedDense S{(const char*)(F.ws + WS_MIXED), (const char*)(F.ws + WS_WOUT), MIXW / 2, NTOK / 256, D / 256, F.G, F.bid, true, WGM_OUT};
    EpiResidBf16 E{F.x, (bf16*)(F.ws + WS_H1B)};
    pg8::gemm_phase<EpiResidBf16, SchedDense, false, true>(F.lds, MIXW / 2, S, E);
}
__device__ __forceinline__ void moe_tables(Frame& F) {
    LAS int* cnt = (LAS int*)(F.lds + MISC_OFF); LAS int* ts = (LAS int*)(F.lds + MISC_OFF + 256);
    __syncthreads();
    if (F.tid < NEXP) cnt[F.tid] = (int)__hip_atomic_load((const unsigned*)(F.ws + WS_CTL) + CW_CNT + F.tid, __ATOMIC_RELAXED, __HIP_MEMORY_SCOPE_AGENT);
    __syncthreads();
    if (F.tid < 64) {
        const int j = F.tid & 31; const int c = (cnt[j] + 255) >> 8; int inc = c;
#pragma unroll
        for (int o = 1; o < 32; o <<= 1) { const int t = __shfl_up(inc, o); if (j >= o) inc += t; }
        if (F.tid < 32) { ts[j] = inc - c; if (j == 31) ts[NEXP] = inc; } }
    __syncthreads();
}
__device__ __forceinline__ void phase_gateup(Frame& F) {
    moe_tables(F);
    SchedMoe S{(const char*)(F.ws + WS_T), (const char*)(F.ws + WS_WGU), D / 2, 8, F.G, F.bid, true, (size_t)2 * DFF * D, WGM_GU,
               (const int*)(F.ws + WS_TAB + TAB_LIST), (const LAS int*)(F.lds + MISC_OFF + 256), (const LAS int*)(F.lds + MISC_OFF), F.b_gate_up};
    EpiSwiglu E{(bf16*)(F.ws + WS_ACT), F.lds};
    pg8::gemm_phase<EpiSwiglu, SchedMoe, true, true>(F.lds, D / 2, S, E);
}
__device__ __forceinline__ void phase_down(Frame& F, int kmul) {
    moe_tables(F);
    SchedMoe S{(const char*)(F.ws + WS_ACT), (const char*)(F.ws + WS_WDN), DFF / 2, 4, F.G, F.bid, false, (size_t)D * DFF, WGM_DN,
               nullptr, (const LAS int*)(F.lds + MISC_OFF + 256), (const LAS int*)(F.lds + MISC_OFF), F.b_down};
    EpiFp8Row E{F.ws + WS_YPAIR, D, F.lds};
    pg8::gemm_phase<EpiFp8Row, SchedMoe, false, true>(F.lds, kmul * DFF / 2, S, E);
}

__device__ __forceinline__ void phase_ssd_naive(Frame& F) {
    const bf16* proj = (const bf16*)(F.ws + WS_PROJ); float* mixraw = (float*)(F.ws + WS_MIXRAW);
    LAS float* sx = (LAS float*)F.lds;
    LAS float* sdt = sx + 16 * 320;
    for (int unit = F.bid; unit < BATCH * 16; unit += F.G) {
        const int b = unit / 16, h = unit % 16, g = h / 8, p = F.tid >> 3, nq = F.tid & 7;
        const float a = -__expf(F.a_log[h]), dsk = F.d_skip[h], dtb = F.dt_bias[h];
        float hs[16];
#pragma unroll
        for (int j = 0; j < 16; ++j) hs[j] = 0.f;
        for (int pos0 = PADROWS; pos0 < LPAD; pos0 += 16) {
            __syncthreads();
            for (int idx = F.tid; idx < 16 * 320; idx += 512) {
                const int tt = idx / 320, c = idx % 320;
                const int xch = c < 64 ? h * 64 + c : (c < 192 ? 1024 + g * 128 + (c - 64) : 1280 + g * 128 + (c - 192));
                float acc = F.conv_b[xch];
#pragma unroll
                for (int k = 0; k < 4; ++k) { const int pp = pos0 + tt - 3 + k; acc += F.conv_w[k * XBCW + xch] * bf2f(proj[((size_t)b * LPAD + pp) * INWP + C_XBC + xch]); }
                sx[tt * 320 + c] = silu_f(acc);
            }
            if (F.tid < 16) sdt[F.tid] = softplus_f(bf2f(proj[((size_t)b * LPAD + pos0 + F.tid) * INWP + C_DT + h]) + dtb);
            __syncthreads();
            for (int tt = 0; tt < 16; ++tt) {
                const float dt = sdt[tt], dA = __expf(dt * a), xp = sx[tt * 320 + p], dx = dt * xp;
                float part = 0.f;
#pragma unroll
                for (int j = 0; j < 16; ++j) { hs[j] = dA * hs[j] + dx * sx[tt * 320 + 64 + nq * 16 + j]; part += sx[tt * 320 + 192 + nq * 16 + j] * hs[j]; }
                part += __shfl_xor(part, 1); part += __shfl_xor(part, 2); part += __shfl_xor(part, 4);
                if (nq == 0) mixraw[((size_t)b * LPAD + pos0 + tt) * MIXW + h * 64 + p] = part + dsk * xp;
            }
        }
    }
    __syncthreads();
}
__device__ __forceinline__ void phase_gla_naive(Frame& F) {
    const bf16* proj = (const bf16*)(F.ws + WS_PROJ); float* mixraw = (float*)(F.ws + WS_MIXRAW);
    LAS float* sq = (LAS float*)F.lds;
    LAS float* sk = sq + 16 * 128; LAS float* sa = sk + 16 * 128; LAS float* sv = sa + 16 * 128;
    for (int unit = (F.G >= 80 ? F.bid - 64 : F.bid); unit < BATCH * 4; unit += F.G) {
        if (unit < 0) continue;
        const int b = unit / 4, h = unit % 4, v = F.tid >> 1, dh = F.tid & 1;
        float S[64];
#pragma unroll
        for (int j = 0; j < 64; ++j) S[j] = 0.f;
        for (int pos0 = PADROWS; pos0 < LPAD; pos0 += 16) {
            __syncthreads();
            for (int idx = F.tid; idx < 16 * 128; idx += 512) {
                const int tt = idx >> 7, d = idx & 127; const size_t rb = ((size_t)b * LPAD + pos0 + tt) * INWP;
                sq[idx] = bf2f(proj[rb + C_Q + h * 128 + d]) * 0.08838834764831845f;
                sk[idx] = bf2f(proj[rb + C_K + h * 128 + d]);
                float z = F.b_decay[h * 128 + d];
#pragma unroll
                for (int r = 0; r < 16; ++r) z += bf2f(proj[rb + C_ALR + r]) * F.w_decay_up[r * 512 + h * 128 + d];
                sa[idx] = __expf(logsigmoid_f(z) * (1.f / 16.f));
            }
            for (int idx = F.tid; idx < 16 * 256; idx += 512) { const int tt = idx >> 8, vv = idx & 255; sv[idx] = bf2f(proj[((size_t)b * LPAD + pos0 + tt) * INWP + C_V + h * 256 + vv]); }
            __syncthreads();
            for (int tt = 0; tt < 16; ++tt) {
                const float vv = sv[tt * 256 + v]; float op = 0.f;
#pragma unroll
                for (int j = 0; j < 64; ++j) { const int d = dh * 64 + j; S[j] = sa[tt * 128 + d] * S[j] + sk[tt * 128 + d] * vv; op += sq[tt * 128 + d] * S[j]; }
                op += __shfl_xor(op, 1);
                if (dh == 0) mixraw[((size_t)b * LPAD + pos0 + tt) * MIXW + 1024 + h * 256 + v] = op;
            }
        }
    }
    __syncthreads();
}
__device__ __forceinline__ void phase_mixnorm(Frame& F) {
    const bf16* proj = (const bf16*)(F.ws + WS_PROJ); const float* mixraw = (const float*)(F.ws + WS_MIXRAW); bf16* mixed = (bf16*)(F.ws + WS_MIXED);
    const int gw = F.bid * 8 + F.wave, NGW = F.G * 8;
    for (int r = gw; r < MROWS; r += NGW) {
        const int p = r % LPAD; if (p < PADROWS) continue;
        const float* mr = mixraw + (size_t)r * MIXW; const bf16* pr = proj + (size_t)r * INWP; bf16* o = mixed + (size_t)r * MIXW;
        for (int g = 0; g < 2; ++g) {
            float y[8]; float s = 0.f;
#pragma unroll
            for (int j = 0; j < 8; ++j) { const int c = g * 512 + F.lane * 8 + j; y[j] = mr[c] * silu_f(bf2f(pr[C_Z + c])); s += y[j] * y[j]; }
            const float rstd = rsqrtf(wave_sum(s) * (1.f / 512.f) + EPS);
            u32x4 w; unsigned ww[4];
#pragma unroll
            for (int j = 0; j < 4; ++j) { const int c = g * 512 + F.lane * 8 + 2 * j; ww[j] = pk2(y[2 * j] * rstd * F.ssd_norm_w[c], y[2 * j + 1] * rstd * F.ssd_norm_w[c + 1]); }
            w.x = ww[0]; w.y = ww[1]; w.z = ww[2]; w.w = ww[3];
            *(u32x4*)(o + g * 512 + F.lane * 8) = w;
        }
        for (int h = 0; h < 4; ++h) {
            float y[4]; float s = 0.f;
#pragma unroll
            for (int j = 0; j < 4; ++j) { y[j] = mr[1024 + h * 256 + F.lane * 4 + j]; s += y[j] * y[j]; }
            const float rstd = rsqrtf(wave_sum(s) * (1.f / 256.f) + EPS);
            unsigned ww[2];
#pragma unroll
            for (int j = 0; j < 2; ++j) { const int vv = F.lane * 4 + 2 * j;
                const float a0 = y[2 * j] * rstd * F.gla_norm_w[vv] * silu_f(bf2f(pr[C_G + h * 256 + vv])), a1 = y[2 * j + 1] * rstd * F.gla_norm_w[vv + 1] * silu_f(bf2f(pr[C_G + h * 256 + vv + 1]));
                ww[j] = pk2(a0, a1); }
            *(u32x2*)(o + 1024 + h * 256 + F.lane * 4) = (u32x2){ww[0], ww[1]};
        }
    }
}


constexpr int NCHUNK = 65;
__device__ __forceinline__ unsigned swz(int row, int chunk) { return (unsigned)(row * 256 + ((chunk ^ (row & 15)) << 4)); }
__device__ __forceinline__ bf16x8 ldfrag(const LAS unsigned char* buf, int row, int chunk) { return *(const LAS bf16x8*)(buf + swz(row, chunk)); }
__device__ __forceinline__ f32x4 mfma16(bf16x8 a, bf16x8 b, f32x4 c) { return __builtin_amdgcn_mfma_f32_16x16x32_bf16(a, b, c, 0, 0, 0); }
__device__ __forceinline__ u32x4 pack8(const float (&v)[8]) { u32x4 w; w.x = pk2(v[0], v[1]); w.y = pk2(v[2], v[3]); w.z = pk2(v[4], v[5]); w.w = pk2(v[6], v[7]); return w; }
__device__ __forceinline__ float bflo(unsigned w) { return __uint_as_float(w << 16); }
__device__ __forceinline__ float bfhi(unsigned w) { return __uint_as_float(w & 0xffff0000u); }
__device__ __forceinline__ bf16x8 st8_frag(u32x2 w) { const f32x2 a = __builtin_amdgcn_cvt_pk_f32_fp8(w.x, false), b = __builtin_amdgcn_cvt_pk_f32_fp8(w.x, true), c = __builtin_amdgcn_cvt_pk_f32_fp8(w.y, false), d = __builtin_amdgcn_cvt_pk_f32_fp8(w.y, true);
    const u32x4 o = {pk2(a[0], a[1]), pk2(b[0], b[1]), pk2(c[0], c[1]), pk2(d[0], d[1])}; return __builtin_bit_cast(bf16x8, o); }
__device__ __forceinline__ void st8_unpack(u32x2 w, float (&v)[8]) { const f32x2 a = __builtin_amdgcn_cvt_pk_f32_fp8(w.x, false), b = __builtin_amdgcn_cvt_pk_f32_fp8(w.x, true), c = __builtin_amdgcn_cvt_pk_f32_fp8(w.y, false), d = __builtin_amdgcn_cvt_pk_f32_fp8(w.y, true);
    v[0] = a[0]; v[1] = a[1]; v[2] = b[0]; v[3] = b[1]; v[4] = c[0]; v[5] = c[1]; v[6] = d[0]; v[7] = d[1]; }
__device__ __forceinline__ u32x2 st8_pack(const float (&v)[8]) { return (u32x2){pk4_fp8(v[0], v[1], v[2], v[3]), pk4_fp8(v[4], v[5], v[6], v[7])}; }
__device__ __forceinline__ void sync_lds() { asm volatile("s_waitcnt lgkmcnt(0)\n\ts_barrier" ::: "memory"); }
__device__ __forceinline__ int draw(unsigned* head) { return (int)atomicInc(head, 0xFFFFFFFFu); }

__device__ __forceinline__ void ssd_dt_acs(Frame& F, int lane, unsigned short dr0, unsigned short dr1, float a, float bias, int c, LAS float* dts, LAS float* acss) {
    const int hl = F.wave; const int t0 = 2 * lane;
    float d0 = softplus_f(bf2f(dr0) + bias), d1 = softplus_f(bf2f(dr1) + bias);
    if (c * 128 + t0 < PADROWS) d0 = 0.f;
    if (c * 128 + t0 + 1 < PADROWS) d1 = 0.f;
    const float v0 = d0 * a, v1 = d1 * a; float s = v0 + v1;
#pragma unroll
    for (int o = 1; o < 64; o <<= 1) { const float t = __shfl_up(s, o); if (lane >= o) s += t; }
    dts[hl * 128 + t0] = d0; dts[hl * 128 + t0 + 1] = d1; acss[hl * 128 + t0] = s - v1; acss[hl * 128 + t0 + 1] = s;
}

constexpr size_t SB_CN = 0, SB_BN = 32768, SB_XT0 = 65536, SB_XT1 = 131072, SB_DTA = 196608, SB_BYTES = 204800;
constexpr size_t GB_QD = 0, GB_KI = 32768, GB_VT = 65536, GB_BYTES = 131072;
constexpr size_t WS_GBLOB = WS_R2 + 130 * MiB;
static_assert((size_t)BATCH * NCHUNK * 2 * SB_BYTES <= (size_t)NTOK * D * 4 && WS_GBLOB + (size_t)BATCH * NCHUNK * 4 * GB_BYTES <= WS_MIXED, "blob map");

__device__ __forceinline__ void conv_load(const bf16* proj, long grow0, int t0, int xch, u32x2 (&raw)[11]) {
    long r0 = grow0 + t0 - 3; if (r0 < 0) r0 = 0;
    const int ja = 16 - (int)(r0 & 15);
    const bf16* pa = proj + paddr(r0, C_XBC + xch); const bf16* pb = proj + paddr(r0 + ja, C_XBC + xch) - 8 * ja;
#pragma unroll
    for (int j = 0; j < 11; ++j) raw[j] = *(const u32x2*)((j < ja ? pa : pb) + 8 * j);
}
constexpr int CONVW_OFF = 114688;
constexpr int HEADT_OFF = CONVW_OFF + 5 * XBCW * 4;
static_assert(HEADT_OFF + 128 <= LDS_BYTES - 32, "head table");
struct ConvW { f32x4 wk[4], bb; };
__device__ __forceinline__ ConvW conv_wload(const LAS float* cw, int xch) { ConvW c; c.bb = *(const LAS f32x4*)(cw + 4 * XBCW + xch);
#pragma unroll
    for (int k = 0; k < 4; ++k) c.wk[k] = *(const LAS f32x4*)(cw + k * XBCW + xch);
    return c; }
__device__ __forceinline__ void conv_compute(const u32x2 (&raw)[11], const ConvW& cw, int pos0, int t0, float (&out)[8][4]) {
    const f32x4 (&wk)[4] = cw.wk; const f32x4 bb = cw.bb;
#pragma unroll
    for (int t = 0; t < 8; ++t) { float a0 = bb[0], a1 = bb[1], a2 = bb[2], a3 = bb[3];
#pragma unroll
        for (int k = 0; k < 4; ++k) { const u32x2 w = raw[t + k]; a0 += wk[k][0] * bflo(w.x); a1 += wk[k][1] * bfhi(w.x); a2 += wk[k][2] * bflo(w.y); a3 += wk[k][3] * bfhi(w.y); }
        const bool pad = pos0 + t0 + t < PADROWS;
        out[t][0] = pad ? 0.f : silu_f(a0); out[t][1] = pad ? 0.f : silu_f(a1); out[t][2] = pad ? 0.f : silu_f(a2); out[t][3] = pad ? 0.f : silu_f(a3); }
}
__device__ __forceinline__ void put_transposed(LAS unsigned char* img, int row0, int tg, const float (&o)[8][4]) {
#pragma unroll
    for (int i = 0; i < 4; ++i) { float v[8];
#pragma unroll
        for (int t = 0; t < 8; ++t) v[t] = o[t][i];
        *(LAS u32x4*)(img + swz(row0 + i, tg)) = pack8(v); }
}
__device__ __forceinline__ void put_natural_global(unsigned char* img, int tok0, int cl, const float (&o)[8][4]) {
#pragma unroll
    for (int t = 0; t < 8; ++t) *(u32x2*)(img + swz(tok0 + t, cl >> 3) + (cl & 7) * 2) = (u32x2){pk2(o[t][0], o[t][1]), pk2(o[t][2], o[t][3])};
}
__device__ __forceinline__ void blob_out(unsigned char* g, const LAS unsigned char* l, int bytes, int tid) {
    for (int o = tid * 16; o < bytes; o += 512 * 16) *(u32x4*)(g + o) = *(const LAS u32x4*)(l + o);
}
__device__ __forceinline__ void blob_in(const unsigned char* g, LAS unsigned char* l, int bytes, int wave, int lane) {
    for (int o = wave * 1024; o < bytes; o += 8 * 1024) __builtin_amdgcn_global_load_lds((const unsigned*)(g + o + lane * 16), (LAS unsigned*)(l + o), 16, 0, 0);
}

struct UQ { volatile LAS int* slot; unsigned* head; int q3; };
constexpr int NU_SSD = BATCH * NCHUNK * 2, NU_ALL = BATCH * NCHUNK * 2 + BATCH * NCHUNK * 4;
__device__ __forceinline__ void uq_init(Frame& F, UQ& Q, unsigned* head) {
    Q.slot = (volatile LAS int*)(F.lds + LDS_BYTES - 32); Q.head = head; Q.q3 = 0;
    __syncthreads();
    if (F.tid == 0) { const int a = draw(head), b = draw(head); Q.slot[0] = a; Q.slot[1] = b; }
}
__device__ __forceinline__ bool uq_top(UQ& Q, int& u, int& un) { sync_lds(); u = Q.slot[0]; un = Q.slot[1]; return u < NU_ALL; }
__device__ __forceinline__ void uq_fetch(Frame& F, UQ& Q) { if (F.tid == 0) Q.q3 = draw(Q.head); }
__device__ __forceinline__ void uq_publish(Frame& F, UQ& Q, int un) { if (F.tid == 0) { Q.slot[0] = un; Q.slot[1] = Q.q3; } }

struct SsdIn { u32x2 rB[11], rC[11], rX0[11], rX1[11]; unsigned short dr0, dr1; };
__device__ __forceinline__ void ssd_load_dt(const bf16* proj, long grow0, int g, int wave, int lane, SsdIn& I) { const int h = g * 8 + wave; I.dr0 = proj[paddr(grow0 + 2 * lane, C_DT + h)]; I.dr1 = proj[paddr(grow0 + 2 * lane + 1, C_DT + h)]; }
__device__ __forceinline__ void m1_ssd(Frame& F, int u, int une, SsdIn& I) {
    int tid = threadIdx.x; asm volatile("" : "+v"(tid)); const int lane = tid & 63;
    const int g = u & 1, bc = u >> 1, b = bc / NCHUNK, c = bc % NCHUNK, gn = une & 1, bcn = une >> 1;
    const bf16* proj = (const bf16*)(F.ws + WS_PROJ); unsigned char* sst = F.ws + WS_SST; float* cdec = (float*)(F.ws + WS_TAB + TAB_CDEC);
    unsigned char* blob = (unsigned char*)F.out + (size_t)u * SB_BYTES;
    LAS unsigned char* BT = F.lds; LAS unsigned char* XT = F.lds + 32768;
    LAS float* dts = (LAS float*)(F.lds + 98304); LAS float* acss = dts + 1024; LAS float* scs = acss + 1024;
    const long grow0n = (long)(bcn / NCHUNK) * LPAD + (bcn % NCHUNK) * 128; const int pos0 = c * 128, fr = lane & 15, fq = lane >> 4;
    const int cqB = tid & 31, tgB = tid >> 5;
    const int cqX = tid & 63, tgX = tid >> 6;
    const LAS float* cws = (const LAS float*)(F.lds + CONVW_OFF);
    { const LAS float* hts = (const LAS float*)(F.lds + HEADT_OFF); ssd_dt_acs(F, lane, I.dr0, I.dr1, hts[g * 8 + F.wave], hts[16 + g * 8 + F.wave], c, dts, acss); }
    asm volatile("" ::: "memory");
    ssd_load_dt(proj, grow0n, gn, F.wave, lane, I);
    { float o[8][4];
      conv_compute(I.rB, conv_wload(cws, 1024 + g * 128 + 4 * cqB), pos0, 8 * tgB, o); put_transposed(BT, 4 * cqB, tgB, o);
      asm volatile("" ::: "memory"); conv_load(proj, grow0n, 8 * tgB, 1024 + gn * 128 + 4 * cqB, I.rB); asm volatile("" ::: "memory");
      put_natural_global(blob + SB_BN, 8 * tgB, 4 * cqB, o);
      conv_compute(I.rC, conv_wload(cws, 1280 + g * 128 + 4 * cqB), pos0, 8 * tgB, o);
      asm volatile("" ::: "memory"); conv_load(proj, grow0n, 8 * tgB, 1280 + gn * 128 + 4 * cqB, I.rC); asm volatile("" ::: "memory");
      put_natural_global(blob + SB_CN, 8 * tgB, 4 * cqB, o); }
#pragma unroll 1
    for (int pass = 0; pass < 2; ++pass) {
        { float o[8][4];
          const ConvW wX = conv_wload(cws, g * 512 + pass * 256 + 4 * cqX);
          conv_compute(I.rX0, wX, pos0, 8 * tgX, o); put_transposed(XT, 4 * cqX, tgX, o);
          conv_compute(I.rX1, wX, pos0, 8 * (tgX + 8), o); put_transposed(XT, 4 * cqX, tgX + 8, o); }
        asm volatile("" ::: "memory");
        {
            const long gr = pass == 0 ? (long)b * LPAD + c * 128 : grow0n; const int xc = pass == 0 ? g * 512 + 256 + 4 * cqX : gn * 512 + 4 * cqX;
            conv_load(proj, gr, 8 * tgX, xc, I.rX0); conv_load(proj, gr, 8 * (tgX + 8), xc, I.rX1); }
        sync_lds();
        if (pass == 0) { *(u32x4*)(blob + SB_DTA + tid * 16) = *(const LAS u32x4*)((const LAS unsigned char*)dts + tid * 16);
            for (int i = tid; i < 1024; i += 512) { const int hl = i >> 7; scs[i] = dts[i] * __expf(acss[hl * 128 + 127] - acss[i]); }
            sync_lds(); }
        { unsigned char* xb = blob + (pass ? SB_XT1 : SB_XT0);
#pragma unroll
          for (int o = 0; o < 8; ++o) *(u32x4*)(xb + tid * 16 + o * 8192) = *(const LAS u32x4*)(XT + tid * 16 + o * 8192); }
        const int hh = F.wave >> 1, nh = F.wave & 1, hl = 4 * pass + hh;
        f32x4 acc[4][4];
#pragma unroll
        for (int pt = 0; pt < 4; ++pt)
#pragma unroll
            for (int nt = 0; nt < 4; ++nt) acc[pt][nt] = (f32x4){0.f, 0.f, 0.f, 0.f};
#pragma unroll 1
        for (int ks = 0; ks < 4; ++ks) { bf16x8 Bf[4], Xf[4];
#pragma unroll
            for (int nt = 0; nt < 4; ++nt) Bf[nt] = ldfrag(BT, 64 * nh + 16 * nt + fr, 4 * ks + fq);
            const f32x4 s0 = *(const LAS f32x4*)(scs + hl * 128 + 32 * ks + 8 * fq), s1 = *(const LAS f32x4*)(scs + hl * 128 + 32 * ks + 8 * fq + 4);
#pragma unroll
            for (int pt = 0; pt < 4; ++pt) { const u32x4 w = *(const LAS u32x4*)(XT + swz(hh * 64 + 16 * pt + fr, 4 * ks + fq));
                const float v[8] = {bflo(w.x) * s0[0], bfhi(w.x) * s0[1], bflo(w.y) * s0[2], bfhi(w.y) * s0[3], bflo(w.z) * s1[0], bfhi(w.z) * s1[1], bflo(w.w) * s1[2], bfhi(w.w) * s1[3]};
                const u32x4 pw = pack8(v); Xf[pt] = __builtin_bit_cast(bf16x8, pw); }
#pragma unroll
            for (int pt = 0; pt < 4; ++pt)
#pragma unroll
                for (int nt = 0; nt < 4; ++nt) acc[pt][nt] = mfma16(Bf[nt], Xf[pt], acc[pt][nt]); }
        const int h = g * 8 + hl; unsigned char* base = sst + ((size_t)bc * 16 + h) * 8192;
#pragma unroll
        for (int pt = 0; pt < 4; ++pt)
#pragma unroll
            for (int nt = 0; nt < 4; ++nt) { const f32x4 v = acc[pt][nt]; *(unsigned*)(base + (16 * pt + fr) * 128 + 64 * nh + 16 * nt + 4 * fq) = pk4_fp8(v[0], v[1], v[2], v[3]); }
        sync_lds();
    }
    if (tid < 8) cdec[(size_t)bc * 16 + g * 8 + tid] = __expf(acss[tid * 128 + 127]);
}

__device__ __forceinline__ float gla_gcs(Frame& F, int tid, int c, const LAS float* zl, LAS float* qtot, const float bd, float (&gcs)[32]) {
    const int d = tid & 127, tq = tid >> 7;
    float run = 0.f;
#pragma unroll
    for (int i = 0; i < 32; ++i) { const int s = 32 * tq + i; const float z = zl[s * 128 + d] + bd;
        const float la = (c * 128 + s < PADROWS) ? 0.f : logsigmoid_f(z) * (1.f / 16.f);
        run += la; gcs[i] = run;
        if ((i & 3) == 3) asm volatile("" ::: "memory"); }
    qtot[tq * 128 + d] = run;
    sync_lds();
    const float q0 = qtot[d], q1 = qtot[128 + d], q2 = qtot[256 + d], q3 = qtot[384 + d];
    const float off = (tq > 0 ? q0 : 0.f) + (tq > 1 ? q1 : 0.f) + (tq > 2 ? q2 : 0.f);
#pragma unroll
    for (int i = 0; i < 32; ++i) gcs[i] += off;
    return (q0 + q1) + (q2 + q3);
}
struct GlaIn { u32x4 rq[4], rk[4]; u32x2 rv[2][8]; unsigned short ra[4]; float wd[8], bd; };
__device__ __forceinline__ void gla_load_qka(const bf16* proj, size_t grow0, int h, int tid, GlaIn& I) {
#pragma unroll
    for (int i = 0; i < 4; ++i) {
        const int tok = 16 * (tid >> 6) + (tid & 15), cg = 8 * (4 * i + ((tid >> 4) & 3));
        I.rq[i] = __builtin_nontemporal_load((const u32x4*)(proj + paddr(grow0 + tok, C_Q + h * 128 + cg))); I.rk[i] = __builtin_nontemporal_load((const u32x4*)(proj + paddr(grow0 + tok, C_K + h * 128 + cg))); }
#pragma unroll
    for (int i = 0; i < 4; ++i) I.ra[i] = proj[paddr(grow0 + (tid >> 4), C_ALR + (tid & 15)) + prow16(2 * i)];
}
__device__ __forceinline__ void gla_load_v(const bf16* proj, size_t grow0, int h, int tid, GlaIn& I) {
#pragma unroll
    for (int k = 0; k < 2; ++k)
#pragma unroll
        for (int t = 0; t < 8; ++t) I.rv[k][t] = *(const u32x2*)(proj + paddr(grow0 + 8 * (tid >> 6), C_V + h * 256 + 4 * (tid & 63)) + prow16(4 * k) + 8 * t);
}
__device__ __forceinline__ void gla_load_wd(Frame& F, int h, int tid, GlaIn& I) {
#pragma unroll
    for (int j = 0; j < 8; ++j) I.wd[j] = F.w_decay_up[(8 * ((tid >> 4) & 1) + j) * 512 + h * 128 + 16 * (tid >> 6) + (tid & 15)];
    I.bd = F.b_decay[h * 128 + (tid & 127)];
}
__device__ __forceinline__ void m1_gla(Frame& F, int j, int jn, int un, UQ& Q, GlaIn& I) {
    int tid = threadIdx.x; asm volatile("" : "+v"(tid)); const int lane = tid & 63;
    const int h = j & 3, bc = j >> 2, b = bc / NCHUNK, c = bc % NCHUNK, hn = jn & 3, bcn = jn >> 2;
    const bf16* proj = (const bf16*)(F.ws + WS_PROJ); unsigned char* gst = F.ws + WS_GST; float* gdec = (float*)(F.ws + WS_TAB + TAB_GDEC);
    unsigned char* blob = F.ws + WS_GBLOB + (size_t)j * GB_BYTES;
    LAS unsigned char* Qd = F.lds; LAS unsigned char* Ki = F.lds + 32768; LAS unsigned char* KiT = F.lds + 65536; LAS unsigned char* VT = F.lds;
    LAS float* zl = (LAS float*)(F.lds + 65536);
    LAS unsigned short* alrb = (LAS unsigned short*)(F.lds + 131072); LAS float* qtot = (LAS float*)(F.lds + 135168); LAS float* egl = qtot + 512;
    const size_t grow0n = (size_t)(bcn / NCHUNK) * LPAD + (bcn % NCHUNK) * 128; const int fr = lane & 15, fq = lane >> 4;
    uq_fetch(F, Q);
#pragma unroll
    for (int i = 0; i < 4; ++i) { const int tok = 16 * (tid >> 6) + (tid & 15), ch = 4 * i + ((tid >> 4) & 3); *(LAS u32x4*)(Qd + swz(tok, ch)) = I.rq[i]; *(LAS u32x4*)(Ki + swz(tok, ch)) = I.rk[i]; alrb[tid + 512 * i] = I.ra[i]; }
    asm volatile("" ::: "memory");
    gla_load_qka(proj, grow0n, hn, tid, I);
    sync_lds();
    {
        u32x4 bw;
        { unsigned t16[8];
#pragma unroll
          for (int jj = 0; jj < 8; ++jj) { const float w = I.wd[jj]; const unsigned hi = f2bf(w); t16[jj] = fq < 2 ? hi : f2bf(w - bf2f((bf16)hi)); }
          bw = (u32x4){t16[0] | (t16[1] << 16), t16[2] | (t16[3] << 16), t16[4] | (t16[5] << 16), t16[6] | (t16[7] << 16)}; }
        const bf16x8 Bf = __builtin_bit_cast(bf16x8, bw);
#pragma unroll
        for (int st = 0; st < 8; ++st) { const u32x4 aw = *(const LAS u32x4*)((const LAS unsigned char*)alrb + (16 * st + fr) * 32 + 16 * (fq & 1));
            const f32x4 zt = mfma16(__builtin_bit_cast(bf16x8, aw), Bf, (f32x4){0.f, 0.f, 0.f, 0.f});
#pragma unroll
            for (int r = 0; r < 4; ++r) zl[(16 * st + 4 * fq + r) * 128 + 16 * F.wave + fr] = zt[r]; }
    }
    sync_lds();
    { float gcs[32]; const float glast = gla_gcs(F, tid, c, zl, qtot, I.bd, gcs); const int d = tid & 127, tq = tid >> 7;
      asm volatile("" ::: "memory");
      gla_load_wd(F, hn, tid, I);
      uq_publish(F, Q, un);
#pragma unroll
      for (int jj = 0; jj < 4; ++jj) { float kt[8];
#pragma unroll
          for (int t = 0; t < 8; ++t) { const int s = 32 * tq + 8 * jj + t; LAS bf16* qp = (LAS bf16*)(Qd + swz(s, d >> 3) + (d & 7) * 2); LAS bf16* kp = (LAS bf16*)(Ki + swz(s, d >> 3) + (d & 7) * 2);
              const float gs = gcs[8 * jj + t]; const float qv = bf2f(*qp) * 0.08838834764831845f * __expf(gs), kv = bf2f(*kp) * __expf(-gs);
              *qp = (bf16)f2bf(qv); const unsigned kb = f2bf(kv); *kp = (bf16)kb; kt[t] = __uint_as_float(kb << 16); }
          *(LAS u32x4*)(KiT + swz(d, 4 * tq + jj)) = pack8(kt); asm volatile("" ::: "memory"); }
      if (tq == 0) { const float e = __expf(glast); egl[d] = e; gdec[(size_t)j * 128 + d] = e; } }
    sync_lds();
#pragma unroll
    for (int o = 0; o < 8; ++o) *(u32x4*)(blob + GB_QD + tid * 16 + o * 8192) = *(const LAS u32x4*)(Qd + tid * 16 + o * 8192);
    sync_lds();
#pragma unroll
    for (int k = 0; k < 2; ++k) { float v[4][8];
#pragma unroll
        for (int t = 0; t < 8; ++t) { const u32x2 w = I.rv[k][t]; v[0][t] = bflo(w.x); v[1][t] = bfhi(w.x); v[2][t] = bflo(w.y); v[3][t] = bfhi(w.y); }
#pragma unroll
        for (int i = 0; i < 4; ++i) *(LAS u32x4*)(VT + swz(4 * (tid & 63) + i, (tid >> 6) + 8 * k)) = pack8(v[i]); }
    asm volatile("" ::: "memory");
    gla_load_v(proj, grow0n, hn, tid, I);
    sync_lds();
    f32x4 acc[2][8];
#pragma unroll
    for (int vt = 0; vt < 2; ++vt)
#pragma unroll
        for (int dt = 0; dt < 8; ++dt) acc[vt][dt] = (f32x4){0.f, 0.f, 0.f, 0.f};
#pragma unroll 1
    for (int ks = 0; ks < 4; ++ks) { bf16x8 Kf[8], Vf[2];
#pragma unroll
        for (int dt = 0; dt < 8; ++dt) Kf[dt] = ldfrag(KiT, 16 * dt + fr, 4 * ks + fq);
#pragma unroll
        for (int vt = 0; vt < 2; ++vt) Vf[vt] = ldfrag(VT, 32 * F.wave + 16 * vt + fr, 4 * ks + fq);
#pragma unroll
        for (int vt = 0; vt < 2; ++vt)
#pragma unroll
            for (int dt = 0; dt < 8; ++dt) acc[vt][dt] = mfma16(Kf[dt], Vf[vt], acc[vt][dt]); }
    unsigned char* base = gst + (size_t)j * 32768;
#pragma unroll
    for (int dt = 0; dt < 8; ++dt) { const f32x4 e = *(const LAS f32x4*)(egl + 16 * dt + 4 * fq);
#pragma unroll
        for (int vt = 0; vt < 2; ++vt) { const f32x4 v = acc[vt][dt] * e; *(unsigned*)(base + (32 * F.wave + 16 * vt + fr) * 128 + 16 * dt + 4 * fq) = pk4_fp8(v[0], v[1], v[2], v[3]); } }
}
__device__ __forceinline__ void phase_m1(Frame& F, int which) {
    if (which != 0) return;
    { LAS float* cws = (LAS float*)(F.lds + CONVW_OFF);
      for (int i = F.tid; i < 4 * XBCW; i += 512) cws[i] = F.conv_w[i];
      for (int i = F.tid; i < XBCW; i += 512) cws[4 * XBCW + i] = F.conv_b[i];
      if (F.tid < 16) { LAS float* hts = (LAS float*)(F.lds + HEADT_OFF); hts[F.tid] = -__expf(F.a_log[F.tid]); hts[16 + F.tid] = F.dt_bias[F.tid]; }
      __syncthreads(); }
    constexpr int NU_GLA = NU_ALL - NU_SSD;
    auto rs = [](int q) { return (NU_SSD - 1 - q) ^ 1; };
    auto rg = [&](int q) { return (NU_GLA - 1 - q) ^ 3; };
    UQ Q; uq_init(F, Q, (unsigned*)(F.ws + WS_CTL) + CW_Q);
    int u, un; bool more = uq_top(Q, u, un);
    if (more && u < NU_SSD) {
        SsdIn I;
        { int tid = threadIdx.x; asm volatile("" : "+v"(tid)); const int ur = rs(u), g = ur & 1, bc = ur >> 1; const long grow0 = (long)(bc / NCHUNK) * LPAD + (bc % NCHUNK) * 128; const bf16* proj = (const bf16*)(F.ws + WS_PROJ);
          ssd_load_dt(proj, grow0, g, F.wave, tid & 63, I);
          conv_load(proj, grow0, 8 * (tid >> 5), 1024 + g * 128 + 4 * (tid & 31), I.rB); conv_load(proj, grow0, 8 * (tid >> 5), 1280 + g * 128 + 4 * (tid & 31), I.rC);
          conv_load(proj, grow0, 8 * (tid >> 6), g * 512 + 4 * (tid & 63), I.rX0); conv_load(proj, grow0, 8 * ((tid >> 6) + 8), g * 512 + 4 * (tid & 63), I.rX1); }
        while (more && u < NU_SSD) {
            uq_fetch(F, Q);
            m1_ssd(F, rs(u), rs(un < NU_SSD ? un : u), I);
            uq_publish(F, Q, un);
            more = uq_top(Q, u, un);
        }
    }
    if (more) {
        GlaIn I;
        { int tid = threadIdx.x; asm volatile("" : "+v"(tid)); const int j = rg(u - NU_SSD), h = j & 3, bc = j >> 2; const size_t grow0 = (size_t)(bc / NCHUNK) * LPAD + (bc % NCHUNK) * 128; const bf16* proj = (const bf16*)(F.ws + WS_PROJ);
          gla_load_qka(proj, grow0, h, tid, I); gla_load_wd(F, h, tid, I); gla_load_v(proj, grow0, h, tid, I); }
        while (more) {
            m1_gla(F, rg(u - NU_SSD), rg((un < NU_ALL ? un : u) - NU_SSD), un, Q, I);
            more = uq_top(Q, u, un);
        }
    }
    __syncthreads();
}

__device__ __forceinline__ void phase_m2(Frame& F, int probe) {
    unsigned char* sst = F.ws + (probe ? WS_MIXED : WS_SST); unsigned char* gst = F.ws + (probe ? WS_MIXED + 65 * MiB : WS_GST); const float* cdec = (const float*)(F.ws + WS_TAB + TAB_CDEC); const float* gdec = (const float*)(F.ws + WS_TAB + TAB_GDEC);
    const int tid = threadIdx.x;
    for (int t = F.bid * 512 + tid; t < 131072; t += F.G * 512) {
        const int type = t >> 16, idx = t & 65535, b = idx >> 14;
        float run[8];
#pragma unroll
        for (int j = 0; j < 8; ++j) run[j] = 0.f;
        if (type == 0) {
            const int n8 = idx & 15, p = (idx >> 4) & 63, h = (idx >> 10) & 15;
#pragma unroll 5
            for (int c = 0; c < NCHUNK; ++c) { u32x2* ptr = (u32x2*)(sst + (((size_t)b * NCHUNK + c) * 16 + h) * 8192 + p * 128 + n8 * 8); float lv[8]; st8_unpack(__builtin_nontemporal_load(ptr), lv); const float dc = cdec[((size_t)b * NCHUNK + c) * 16 + h];
                __builtin_nontemporal_store(st8_pack(run), ptr);
#pragma unroll
                for (int j = 0; j < 8; ++j) run[j] = dc * run[j] + lv[j]; }
        } else {
            const int d8 = idx & 15, v = (idx >> 4) & 255, h = (idx >> 12) & 3;
#pragma unroll 5
            for (int c = 0; c < NCHUNK; ++c) { u32x2* ptr = (u32x2*)(gst + (((size_t)b * NCHUNK + c) * 4 + h) * 32768 + v * 128 + d8 * 8); float lv[8]; st8_unpack(__builtin_nontemporal_load(ptr), lv);
                const float* dp = gdec + (((size_t)b * NCHUNK + c) * 4 + h) * 128 + d8 * 8; const f32x4 d0 = *(const f32x4*)dp, d1 = *(const f32x4*)(dp + 4);
                __builtin_nontemporal_store(st8_pack(run), ptr);
                run[0] = d0.x * run[0] + lv[0]; run[1] = d0.y * run[1] + lv[1]; run[2] = d0.z * run[2] + lv[2]; run[3] = d0.w * run[3] + lv[3];
                run[4] = d1.x * run[4] + lv[4]; run[5] = d1.y * run[5] + lv[5]; run[6] = d1.z * run[6] + lv[6]; run[7] = d1.w * run[7] + lv[7]; }
        }
    }
}

template <int PROBE> __device__ __forceinline__ void m3_ssd_pass(Frame& F, int pass, int b, int c, int g, int lane, const bf16* proj, const unsigned char* sst, const unsigned char* blob, u32x2 (&ypk)[4][4]) {
    LAS unsigned char* Cn = F.lds; LAS unsigned char* CB = F.lds + 32768; LAS unsigned char* XT = F.lds + 65536;
    LAS float* dts = (LAS float*)(F.lds + 131072); LAS float* acss = dts + 1024; LAS float* ssp = acss + 1024;
    const long grow0 = (long)b * LPAD + c * 128; const int fr = lane & 15, fq = lane >> 4;
    const int hh = F.wave & 3, lh = F.wave >> 2;
    const int hl = 4 * pass + hh, h = g * 8 + hl; const float dsk = F.d_skip[h];
    const unsigned char* hp = sst + (((size_t)b * NCHUNK + c) * 16 + h) * 8192;
    u32x2 Hf[4][4];
#pragma unroll
    for (int ks = 0; ks < 4; ++ks)
#pragma unroll
        for (int pt = 0; pt < 4; ++pt) Hf[ks][pt] = *(const u32x2*)(hp + (16 * pt + fr) * 128 + 32 * ks + 8 * fq);
    blob_in(blob + (pass ? SB_XT1 : SB_XT0), XT, 65536, F.wave, lane);
    f32x4 acc[4][4];
#pragma unroll
    for (int pt = 0; pt < 4; ++pt)
#pragma unroll
        for (int i = 0; i < 4; ++i) acc[pt][i] = (f32x4){0.f, 0.f, 0.f, 0.f};
    if (PROBE == 1) { asm volatile("" :: "v"(Hf[0][0]), "v"(Hf[1][1]), "v"(Hf[2][2]), "v"(Hf[3][3])); }
    else
#pragma unroll
    for (int ks = 0; ks < 4; ++ks) { bf16x8 Cf[4];
#pragma unroll
        for (int i = 0; i < 4; ++i) Cf[i] = ldfrag(Cn, 16 * (2 * i + lh) + fr, 4 * ks + fq);
#pragma unroll
        for (int pt = 0; pt < 4; ++pt) { const bf16x8 hf = st8_frag(Hf[ks][pt]);
#pragma unroll
            for (int i = 0; i < 4; ++i) acc[pt][i] = mfma16(hf, Cf[i], acc[pt][i]); }
        asm volatile("" ::: "memory"); }
    float al[4];
#pragma unroll
    for (int i = 0; i < 4; ++i) { al[i] = acss[hl * 128 + 16 * (2 * i + lh) + fr]; const float e = __expf(al[i]);
#pragma unroll
        for (int pt = 0; pt < 4; ++pt) acc[pt][i] = acc[pt][i] * e; }
    asm volatile("s_waitcnt vmcnt(0)" ::: "memory");
    sync_lds();
    if (PROBE != 1)
#pragma unroll 1
    for (int ks = 0; ks < 4; ++ks) { bf16x8 Xf[4];
#pragma unroll
        for (int pt = 0; pt < 4; ++pt) Xf[pt] = ldfrag(XT, hh * 64 + 16 * pt + fr, 4 * ks + fq);
        const f32x4 as0 = *(const LAS f32x4*)(acss + hl * 128 + 32 * ks + 8 * fq), as1 = *(const LAS f32x4*)(acss + hl * 128 + 32 * ks + 8 * fq + 4);
        const f32x4 dt0 = *(const LAS f32x4*)(dts + hl * 128 + 32 * ks + 8 * fq), dt1 = *(const LAS f32x4*)(dts + hl * 128 + 32 * ks + 8 * fq + 4);
#pragma unroll
        for (int i = 0; i < 4; ++i) if (ks <= i) { const int l = 16 * (2 * i + lh) + fr;
            const u32x4 cw = *(const LAS u32x4*)(CB + swz(l, 4 * ks + fq));
            const float cbv[8] = {bflo(cw.x), bfhi(cw.x), bflo(cw.y), bfhi(cw.y), bflo(cw.z), bfhi(cw.z), bflo(cw.w), bfhi(cw.w)};
            float m[8];
#pragma unroll
            for (int j = 0; j < 8; ++j) { const int s = 32 * ks + 8 * fq + j; const float asj = j < 4 ? as0[j & 3] : as1[j & 3], dtj = j < 4 ? dt0[j & 3] : dt1[j & 3];
                float v = (s <= l) ? cbv[j] * __expf(al[i] - asj) * dtj : 0.f; if (s == l) v += dsk; m[j] = v; }
            const u32x4 mw = pack8(m); const bf16x8 Mf = __builtin_bit_cast(bf16x8, mw);
#pragma unroll
            for (int pt = 0; pt < 4; ++pt) acc[pt][i] = mfma16(Xf[pt], Mf, acc[pt][i]); } }
    u32x2 zw[4][4];
#pragma unroll
    for (int i = 0; i < 4; ++i)
#pragma unroll
        for (int pt = 0; pt < 4; ++pt) zw[i][pt] = *(const u32x2*)(proj + paddr(grow0 + 16 * lh + fr, C_Z + h * 64 + 4 * fq) + prow16(2 * i) + (pt >> 1) * 8192 + (pt & 1) * 256);
#pragma unroll
    for (int i = 0; i < 4; ++i) { const int l = 16 * (2 * i + lh) + fr; float ss = 0.f;
#pragma unroll
        for (int pt = 0; pt < 4; ++pt) { const u32x2 z2 = zw[i][pt];
            f32x4 y = acc[pt][i]; y[0] *= silu_f(bflo(z2.x)); y[1] *= silu_f(bfhi(z2.x)); y[2] *= silu_f(bflo(z2.y)); y[3] *= silu_f(bfhi(z2.y));
            const u32x2 yw = (u32x2){pk2(y[0], y[1]), pk2(y[2], y[3])}; ypk[pt][i] = yw;
            const float r0 = bflo(yw.x), r1 = bfhi(yw.x), r2 = bflo(yw.y), r3 = bfhi(yw.y); ss += (r0 * r0 + r1 * r1) + (r2 * r2 + r3 * r3); }
        ss += __shfl_xor(ss, 16); ss += __shfl_xor(ss, 32);
        if (fq == 0) ssp[(pass * 4 + hh) * 128 + l] = ss; }
    asm volatile("s_waitcnt lgkmcnt(0)" ::: "memory");
    sync_lds();
}
template <int PROBE> __device__ __forceinline__ void m3_ssd(Frame& F, int b, int c, int g, bool pre, int un, int une, UQ& Q) {
    int tid = threadIdx.x; asm volatile("" : "+v"(tid)); const int lane = tid & 63;
    const bf16* proj = (const bf16*)(F.ws + WS_PROJ); const unsigned char* sst = F.ws + WS_SST; unsigned char* mixed = F.ws + WS_MIXED;
    const unsigned char* blob = (const unsigned char*)F.out + ((size_t)(b * NCHUNK + c) * 2 + g) * SB_BYTES;
    LAS unsigned char* Cn = F.lds; LAS unsigned char* CB = F.lds + 32768; LAS unsigned char* Bn = F.lds + 65536;
    LAS float* dts = (LAS float*)(F.lds + 131072); LAS float* ssp = dts + 2048;
    const long grow0 = (long)b * LPAD + c * 128; const int fr = lane & 15, fq = lane >> 4;
    const int hh = F.wave & 3, lh = F.wave >> 2;
    if (pre) asm volatile("s_waitcnt vmcnt(24)" ::: "memory");
    else { blob_in(blob + SB_CN, Cn, 32768, F.wave, lane); blob_in(blob + SB_BN, Bn, 32768, F.wave, lane); blob_in(blob + SB_DTA, (LAS unsigned char*)dts, 8192, F.wave, lane);
           asm volatile("s_waitcnt vmcnt(0)" ::: "memory"); }
    sync_lds();
    uq_fetch(F, Q);
    {
        const int lt = F.wave; f32x4 cb[8];
#pragma unroll
        for (int st = 0; st < 8; ++st) cb[st] = (f32x4){0.f, 0.f, 0.f, 0.f};
        if (PROBE != 1)
#pragma unroll
        for (int ks = 0; ks < 4; ++ks) { const bf16x8 Cf = ldfrag(Cn, 16 * lt + fr, 4 * ks + fq);
#pragma unroll
            for (int st = 0; st < 8; ++st) if (st <= lt) { const bf16x8 Bf = ldfrag(Bn, 16 * st + fr, 4 * ks + fq); cb[st] = mfma16(Bf, Cf, cb[st]); } }
        asm volatile("s_waitcnt lgkmcnt(0)" ::: "memory");
        sync_lds();
#pragma unroll
        for (int st = 0; st < 8; ++st) if (st <= lt) *(LAS u32x2*)(CB + swz(16 * lt + fr, 2 * st + (fq >> 1)) + (fq & 1) * 8) = (u32x2){pk2(cb[st][0], cb[st][1]), pk2(cb[st][2], cb[st][3])};
    }
    u32x2 y0[4][4], y1[4][4];
    m3_ssd_pass<PROBE>(F, 0, b, c, g, lane, proj, sst, blob, y0);
    m3_ssd_pass<PROBE>(F, 1, b, c, g, lane, proj, sst, blob, y1);
    uq_publish(F, Q, un);
    f32x4 nw[2][4];
#pragma unroll
    for (int pass = 0; pass < 2; ++pass)
#pragma unroll
        for (int pt = 0; pt < 4; ++pt) nw[pass][pt] = *(const f32x4*)(F.ssd_norm_w + g * 512 + (4 * pass + hh) * 64 + 16 * pt + 4 * fq);
    asm volatile("" ::: "memory");
    { const unsigned char* nblob = (const unsigned char*)F.out + (size_t)une * SB_BYTES;
      blob_in(nblob + SB_CN, Cn, 32768, F.wave, lane); blob_in(nblob + SB_BN, Bn, 32768, F.wave, lane); blob_in(nblob + SB_DTA, (LAS unsigned char*)dts, 8192, F.wave, lane); }
    asm volatile("" ::: "memory");
    if (PROBE == 0)
#pragma unroll
    for (int i = 0; i < 4; ++i) { const int l = 16 * (2 * i + lh) + fr; float tot = 0.f;
#pragma unroll
        for (int k = 0; k < 8; ++k) tot += ssp[k * 128 + l];
        const float rstd = rsqrtf(tot * (1.f / 512.f) + EPS);
#pragma unroll
        for (int pass = 0; pass < 2; ++pass)
#pragma unroll
            for (int pt = 0; pt < 4; ++pt) { const int col = g * 512 + (4 * pass + hh) * 64 + 16 * pt + 4 * fq; const f32x4 w = nw[pass][pt];
                const u32x2 yw = pass ? y1[pt][i] : y0[pt][i];
                *(unsigned*)(mixed + (size_t)(grow0 + l) * MIXW + col) = pk4_fp8(bflo(yw.x) * rstd * w[0], bfhi(yw.x) * rstd * w[1], bflo(yw.y) * rstd * w[2], bfhi(yw.y) * rstd * w[3]); } }
    else { asm volatile("" :: "v"(y0[0][0]), "v"(y0[3][3]), "v"(y1[0][0]), "v"(y1[3][3])); }
}

template <int PROBE> __device__ __forceinline__ void m3_gla(Frame& F, int b, int c, int h, bool pre, int un, int une, u32x2 (&Sf)[4][2], UQ& Q) {
    int tid = threadIdx.x; asm volatile("" : "+v"(tid)); const int lane = tid & 63;
    const bf16* proj = (const bf16*)(F.ws + WS_PROJ); const unsigned char* gst = F.ws + WS_GST; unsigned char* mixed = F.ws + WS_MIXED;
    const unsigned char* blob = F.ws + WS_GBLOB + ((size_t)(b * NCHUNK + c) * 4 + h) * GB_BYTES;
    LAS unsigned char* Qd = F.lds; LAS unsigned char* Ki = F.lds + 32768; LAS unsigned char* P = F.lds + 32768; LAS unsigned char* VT = F.lds + 65536;
    LAS float* ssp = (LAS float*)(F.lds + 131072);
    const size_t grow0 = (size_t)b * LPAD + c * 128; const int fr = lane & 15, fq = lane >> 4;
    u32x2 rv[2][8];
#pragma unroll
    for (int k = 0; k < 2; ++k)
#pragma unroll
        for (int t = 0; t < 8; ++t) rv[k][t] = *(const u32x2*)(proj + paddr(grow0 + 8 * (tid >> 6), C_V + h * 256 + 4 * (tid & 63)) + prow16(4 * k) + 8 * t);
    if (pre) asm volatile("s_waitcnt vmcnt(28)" ::: "memory");
    else { const unsigned char* sp = gst + (((size_t)b * NCHUNK + c) * 4 + h) * 32768;
#pragma unroll
        for (int ks = 0; ks < 4; ++ks)
#pragma unroll
            for (int vt = 0; vt < 2; ++vt) Sf[ks][vt] = *(const u32x2*)(sp + (32 * F.wave + 16 * vt + fr) * 128 + 32 * ks + 8 * fq);
        blob_in(blob, Qd, 65536, F.wave, lane);
        asm volatile("s_waitcnt vmcnt(0)" ::: "memory"); }
#pragma unroll
    for (int k = 0; k < 2; ++k) { const int tg = (tid >> 6) + 8 * k;
        u32x4 r0, r1, r2, r3;
#pragma unroll
        for (int j = 0; j < 4; ++j) { const u32x2 a = rv[k][2 * j], bq = rv[k][2 * j + 1];
            r0[j] = (a.x & 0xffffu) | (bq.x << 16); r1[j] = (a.x >> 16) | (bq.x & 0xffff0000u); r2[j] = (a.y & 0xffffu) | (bq.y << 16); r3[j] = (a.y >> 16) | (bq.y & 0xffff0000u); }
        *(LAS u32x4*)(VT + swz(4 * (tid & 63) + 0, tg)) = r0; *(LAS u32x4*)(VT + swz(4 * (tid & 63) + 1, tg)) = r1; *(LAS u32x4*)(VT + swz(4 * (tid & 63) + 2, tg)) = r2; *(LAS u32x4*)(VT + swz(4 * (tid & 63) + 3, tg)) = r3; }
    sync_lds();
    uq_fetch(F, Q);
    {
        const int lt = F.wave; f32x4 sc[8];
#pragma unroll
        for (int st = 0; st < 8; ++st) sc[st] = (f32x4){0.f, 0.f, 0.f, 0.f};
        if (PROBE != 1)
#pragma unroll
        for (int ks = 0; ks < 4; ++ks) { const bf16x8 Qf = ldfrag(Qd, 16 * lt + fr, 4 * ks + fq);
#pragma unroll
            for (int st = 0; st < 8; ++st) if (st <= lt) { const bf16x8 Kf = ldfrag(Ki, 16 * st + fr, 4 * ks + fq); sc[st] = mfma16(Kf, Qf, sc[st]); } }
        asm volatile("s_waitcnt lgkmcnt(0)" ::: "memory");
        sync_lds();
        const int l = 16 * lt + fr;
#pragma unroll
        for (int st = 0; st < 8; ++st) if (st <= (lt | 1)) { float v[4];
#pragma unroll
            for (int r = 0; r < 4; ++r) { const int s = 16 * st + 4 * fq + r; v[r] = (st <= lt && s <= l) ? sc[st][r] : 0.f; }
            *(LAS u32x2*)(P + swz(l, 2 * st + (fq >> 1)) + (fq & 1) * 8) = (u32x2){pk2(v[0], v[1]), pk2(v[2], v[3])}; }
    }
    f32x4 acc[2][8];
#pragma unroll
    for (int vt = 0; vt < 2; ++vt)
#pragma unroll
        for (int lt = 0; lt < 8; ++lt) acc[vt][lt] = (f32x4){0.f, 0.f, 0.f, 0.f};
    if (PROBE == 1) { asm volatile("" :: "v"(Sf[0][0]), "v"(Sf[1][1]), "v"(Sf[2][0]), "v"(Sf[3][1])); }
    else
#pragma unroll
    for (int ks = 0; ks < 4; ++ks) { bf16x8 Qf[8];
#pragma unroll
        for (int lt = 0; lt < 8; ++lt) Qf[lt] = ldfrag(Qd, 16 * lt + fr, 4 * ks + fq);
#pragma unroll
        for (int vt = 0; vt < 2; ++vt) { const bf16x8 sf = st8_frag(Sf[ks][vt]);
#pragma unroll
            for (int lt = 0; lt < 8; ++lt) acc[vt][lt] = mfma16(sf, Qf[lt], acc[vt][lt]); }
        asm volatile("" ::: "memory"); }
    u32x2 gw[8][2];
#pragma unroll
    for (int lt = 0; lt < 8; ++lt)
#pragma unroll
        for (int vt = 0; vt < 2; ++vt) gw[lt][vt] = *(const u32x2*)(proj + paddr(grow0 + fr, C_G + h * 256 + 32 * F.wave + 16 * vt + 4 * fq) + prow16(lt));
    sync_lds();
    if (PROBE != 1)
#pragma unroll 1
    for (int ks = 0; ks < 4; ++ks) { bf16x8 Vf[2];
#pragma unroll
        for (int vt = 0; vt < 2; ++vt) Vf[vt] = ldfrag(VT, 32 * F.wave + 16 * vt + fr, 4 * ks + fq);
#pragma unroll
        for (int lt = 0; lt < 8; ++lt) if (2 * ks <= lt) { const bf16x8 Pf = ldfrag(P, 16 * lt + fr, 4 * ks + fq);
#pragma unroll
            for (int vt = 0; vt < 2; ++vt) acc[vt][lt] = mfma16(Vf[vt], Pf, acc[vt][lt]); } }
#pragma unroll
    for (int lt = 0; lt < 8; ++lt) { float ss = 0.f;
#pragma unroll
        for (int vt = 0; vt < 2; ++vt) { const f32x4 y = acc[vt][lt]; ss += (y[0] * y[0] + y[1] * y[1]) + (y[2] * y[2] + y[3] * y[3]); }
        ss += __shfl_xor(ss, 16); ss += __shfl_xor(ss, 32);
        if (fq == 0) ssp[F.wave * 128 + 16 * lt + fr] = ss; }
    sync_lds();
    uq_publish(F, Q, un);
    f32x4 nw[2];
#pragma unroll
    for (int vt = 0; vt < 2; ++vt) nw[vt] = *(const f32x4*)(F.gla_norm_w + 32 * F.wave + 16 * vt + 4 * fq);
    asm volatile("" ::: "memory");
    { const unsigned char* sp = gst + (size_t)une * 32768;
#pragma unroll
      for (int ks = 0; ks < 4; ++ks)
#pragma unroll
          for (int vt = 0; vt < 2; ++vt) Sf[ks][vt] = *(const u32x2*)(sp + (32 * F.wave + 16 * vt + fr) * 128 + 32 * ks + 8 * fq);
      blob_in(F.ws + WS_GBLOB + (size_t)une * GB_BYTES, Qd, 65536, F.wave, lane); }
    asm volatile("" ::: "memory");
#pragma unroll
    for (int lt = 0; lt < 8; ++lt) { const int l = 16 * lt + fr; float tot = 0.f;
#pragma unroll
        for (int k = 0; k < 8; ++k) tot += ssp[k * 128 + l];
        const float rstd = rsqrtf(tot * (1.f / 256.f) + EPS);
#pragma unroll
        for (int vt = 0; vt < 2; ++vt) { const int vv = 32 * F.wave + 16 * vt + 4 * fq; const f32x4 w = nw[vt]; const f32x4 y = acc[vt][lt]; const u32x2 g2 = gw[lt][vt];
            const unsigned ow = pk4_fp8(y[0] * rstd * w[0] * silu_f(bflo(g2.x)), y[1] * rstd * w[1] * silu_f(bfhi(g2.x)), y[2] * rstd * w[2] * silu_f(bflo(g2.y)), y[3] * rstd * w[3] * silu_f(bfhi(g2.y)));
            if (PROBE == 0) *(unsigned*)(mixed + (grow0 + l) * MIXW + 1024 + h * 256 + vv) = ow; else asm volatile("" :: "v"(ow)); } }
}
__device__ __forceinline__ void phase_m3(Frame& F, int which) {
    if (which != 0) return;
    UQ Q; uq_init(F, Q, (unsigned*)(F.ws + WS_CTL) + CW_Q + 64);
    int u, un; bool more = uq_top(Q, u, un), pre = false;
    while (more && u < NU_SSD) {
        const bool nx = un < NU_SSD; const int g = u & 1, bc = u >> 1;
        m3_ssd<0>(F, bc / NCHUNK, bc % NCHUNK, g, pre, un, nx ? un : u, Q);
        pre = nx; more = uq_top(Q, u, un);
    }
    asm volatile("s_waitcnt vmcnt(0)" ::: "memory");
    __syncthreads();
    u32x2 Sf[4][2];
#pragma unroll
    for (int ks = 0; ks < 4; ++ks)
#pragma unroll
        for (int vt = 0; vt < 2; ++vt) Sf[ks][vt] = (u32x2){0u, 0u};
    pre = false;
    while (more) {
        const bool nx = un < NU_ALL; const int j = u - NU_SSD, h = j & 3, bc = j >> 2;
        m3_gla<0>(F, bc / NCHUNK, bc % NCHUNK, h, pre, un, (nx ? un : u) - NU_SSD, Sf, Q);
        pre = nx; more = uq_top(Q, u, un);
    }
    asm volatile("s_waitcnt vmcnt(0)" ::: "memory");
    __syncthreads();
}

template <int N> __device__ __forceinline__ int ror16i(int v) { return __builtin_amdgcn_update_dpp(0, v, 0x120 + N, 0xf, 0xf, false); }
template <int N> __device__ __forceinline__ float ror16(float v) { return __int_as_float(ror16i<N>(__float_as_int(v))); }
__device__ __forceinline__ void phase_router(Frame& F, int probe) {
    const LAS u32x4* img = (const LAS u32x4*)F.lds;
    LAS int* sel_e = (LAS int*)(F.lds + MISC_OFF + 1024);
    LAS int* sel_rank = sel_e + 512;
    LAS int* hist = sel_rank + 512;
    LAS int* base = hist + 32;
    const bf16* h1 = (const bf16*)(F.ws + WS_H1B); unsigned char* T = F.ws + WS_T;
    float* gates = (float*)(F.ws + WS_TAB + TAB_GATES); int* pe = (int*)(F.ws + WS_TAB + TAB_PE); int* ps = (int*)(F.ws + WS_TAB + TAB_PS); int* list = (int*)(F.ws + WS_TAB + TAB_LIST);
    unsigned* gcnt = (unsigned*)(F.ws + WS_CTL) + CW_CNT;
    __syncthreads();
    for (int pc = F.tid; pc < 4096; pc += 512) { const int ln = pc & 63, etile = (pc >> 6) & 1, S = pc >> 7, e = 16 * etile + (ln & 15), k0 = 32 * S + 8 * (ln >> 4);
        unsigned hi[8], lo[8];
#pragma unroll
        for (int j = 0; j < 8; ++j) { const float w = F.w_router[(k0 + j) * NEXP + e] * F.ffn_norm_w[k0 + j]; hi[j] = f2bf(w); lo[j] = f2bf(w - bf2f((bf16)hi[j])); }
        ((LAS u32x4*)F.lds)[((S * 2 + etile) * 2 + 0) * 64 + ln] = (u32x4){hi[0] | (hi[1] << 16), hi[2] | (hi[3] << 16), hi[4] | (hi[5] << 16), hi[6] | (hi[7] << 16)};
        ((LAS u32x4*)F.lds)[((S * 2 + etile) * 2 + 1) * 64 + ln] = (u32x4){lo[0] | (lo[1] << 16), lo[2] | (lo[3] << 16), lo[4] | (lo[5] << 16), lo[6] | (lo[7] << 16)}; }
    const int n = F.lane & 15, qd = F.lane >> 4;
    const float b0 = F.b_router[n], b1 = F.b_router[16 + n];
    for (int blk = F.bid; blk < NTOK / 128; blk += F.G) {
        __syncthreads();
        if (F.tid < 32) hist[F.tid] = 0;
        const int row0 = blk * 128 + F.wave * 16;
        const u32x4* xp = (const u32x4*)(h1 + (size_t)(row0 + n) * D) + qd;
        u32x4 xv[8];
#pragma unroll
        for (int p = 0; p < 8; ++p) xv[p] = xp[4 * p];
        f32x4 acc0 = {0.f, 0.f, 0.f, 0.f}, acc1 = {0.f, 0.f, 0.f, 0.f}; float ss = 0.f;
#pragma unroll 1
        for (int S0 = 0; S0 < 32; S0 += 8) {
#pragma unroll
            for (int p = 0; p < 8; ++p) {
                const u32x4 v = xv[p]; const int Sn = S0 + p + 8; xv[p] = xp[4 * (Sn < 32 ? Sn : 31)];
                __builtin_amdgcn_sched_barrier(0);
                const float f[8] = {bflo(v.x), bfhi(v.x), bflo(v.y), bfhi(v.y), bflo(v.z), bfhi(v.z), bflo(v.w), bfhi(v.w)};
                ss += ((f[0] * f[0] + f[1] * f[1]) + (f[2] * f[2] + f[3] * f[3])) + ((f[4] * f[4] + f[5] * f[5]) + (f[6] * f[6] + f[7] * f[7]));
                const LAS u32x4* ip = img + (S0 + p) * 256 + F.lane; const bf16x8 af = __builtin_bit_cast(bf16x8, v);
                const u32x4 h0 = ip[0], l0 = ip[64], h1w = ip[128], l1 = ip[192];
                acc0 = mfma16(af, __builtin_bit_cast(bf16x8, h0), acc0); acc1 = mfma16(af, __builtin_bit_cast(bf16x8, h1w), acc1);
                acc0 = mfma16(af, __builtin_bit_cast(bf16x8, l0), acc0); acc1 = mfma16(af, __builtin_bit_cast(bf16x8, l1), acc1);
            }
        }
        ss += __shfl_xor(ss, 16); ss += __shfl_xor(ss, 32);
        const float rstd = rsqrtf(ss * (1.f / D) + EPS);
#pragma unroll
        for (int reg = 0; reg < 4; ++reg) {
            const float rs = __shfl(rstd, 4 * qd + reg);
            float v0 = acc0[reg] * rs + b0, v1 = acc1[reg] * rs + b1;
            float tl[4]; int te[4];
#pragma unroll
            for (int k = 0; k < 4; ++k) {
                float m = fmaxf(v0, v1);
                m = fmaxf(m, ror16<8>(m)); m = fmaxf(m, ror16<4>(m)); m = fmaxf(m, ror16<2>(m)); m = fmaxf(m, ror16<1>(m));
                int idx = (v0 == m) ? n : ((v1 == m) ? 16 + n : 64);
                idx = min(idx, ror16i<8>(idx)); idx = min(idx, ror16i<4>(idx)); idx = min(idx, ror16i<2>(idx)); idx = min(idx, ror16i<1>(idx));
                tl[k] = m; te[k] = idx;
                if (idx == n) v0 = -INFINITY;
                if (idx == 16 + n) v1 = -INFINITY;
            }
            const float e1 = __expf(tl[1] - tl[0]), e2 = __expf(tl[2] - tl[0]), e3 = __expf(tl[3] - tl[0]); const float inv = 1.f / (1.f + e1 + e2 + e3);
            if (n == 0) { const int lr = F.wave * 16 + 4 * qd + reg; *(f32x4*)(gates + (size_t)(row0 + 4 * qd + reg) * 4) = (f32x4){inv, e1 * inv, e2 * inv, e3 * inv};
#pragma unroll
                for (int k = 0; k < 4; ++k) sel_e[lr * 4 + k] = te[k]; }
        }
        { const f32x4* nwp = (const f32x4*)F.ffn_norm_w + 2 * F.lane; f32x4 nw[2][2];
#pragma unroll
          for (int j = 0; j < 2; ++j) { nw[j][0] = nwp[128 * j]; nw[j][1] = nwp[128 * j + 1]; }
#pragma unroll 4
          for (int rr = 0; rr < 16; ++rr) {
              const float rs = __shfl(rstd, rr);
              const u32x4* xr = (const u32x4*)(h1 + (size_t)(row0 + rr) * D) + F.lane; u32x2* oa = (u32x2*)(T + (size_t)(row0 + rr) * D) + F.lane;
#pragma unroll
              for (int j = 0; j < 2; ++j) { const u32x4 v = xr[64 * j]; const f32x4 wa = nw[j][0], wb = nw[j][1];
                  oa[64 * j] = (u32x2){pk4_fp8(bflo(v.x) * rs * wa.x, bfhi(v.x) * rs * wa.y, bflo(v.y) * rs * wa.z, bfhi(v.y) * rs * wa.w), pk4_fp8(bflo(v.z) * rs * wb.x, bfhi(v.z) * rs * wb.y, bflo(v.w) * rs * wb.z, bfhi(v.w) * rs * wb.w)}; } } }
        __syncthreads();
        if (probe) continue;
        { const int e = sel_e[F.tid]; sel_rank[F.tid] = __hip_atomic_fetch_add((int*)(hist + e), 1, __ATOMIC_RELAXED, __HIP_MEMORY_SCOPE_WORKGROUP); }
        __syncthreads();
        if (F.tid < 32) base[F.tid] = (int)__hip_atomic_fetch_add(gcnt + F.tid, (unsigned)hist[F.tid], __ATOMIC_RELAXED, __HIP_MEMORY_SCOPE_AGENT);
        __syncthreads();
        { const int e = sel_e[F.tid], slot = base[e] + sel_rank[F.tid], row = blk * 128 + (F.tid >> 2);
          list[e * NTOK + slot] = row; pe[(size_t)row * 4 + (F.tid & 3)] = e; ps[(size_t)row * 4 + (F.tid & 3)] = slot; }
    }
    __syncthreads();
}

__device__ __forceinline__ void phase_combine(Frame& F, int probe) {
    moe_tables(F);
    const LAS int* ts = (const LAS int*)(F.lds + MISC_OFF + 256);
    const bf16* yp = (const bf16*)(F.ws + WS_YPAIR); const float* gates = (const float*)(F.ws + WS_TAB + TAB_GATES); const int* pe = (const int*)(F.ws + WS_TAB + TAB_PE); const int* ps = (const int*)(F.ws + WS_TAB + TAB_PS);
    const int gw = F.bid * 8 + F.wave, NGW = F.G * 8;
    for (int row = gw; row < NTOK; row += NGW) {
        f32x4* xr = (f32x4*)(F.out + (size_t)row * D) + F.lane;
        const u32x2* hr = (const u32x2*)((const bf16*)(F.ws + WS_H1B) + (size_t)row * D) + F.lane;
        f32x4 v[4];
#pragma unroll
        for (int j = 0; j < 4; ++j) { const u32x2 w = __builtin_nontemporal_load(hr + 64 * j); v[j] = (f32x4){bflo(w.x), bfhi(w.x), bflo(w.y), bfhi(w.y)}; }
        const f32x4 gt = *(const f32x4*)(gates + (size_t)row * 4);
#pragma unroll
        for (int k = 0; k < 4; ++k) { const int e = pe[(size_t)row * 4 + k], slot = ps[(size_t)row * 4 + k]; const float gk = gt[k];
            const unsigned* yr = (const unsigned*)((const unsigned char*)yp + ((size_t)ts[e] * 256 + slot) * D) + F.lane;
#pragma unroll
            for (int j = 0; j < 4; ++j) { const unsigned w = __builtin_nontemporal_load(yr + 64 * j); const f32x2 lo = __builtin_amdgcn_cvt_pk_f32_fp8(w, false), hi = __builtin_amdgcn_cvt_pk_f32_fp8(w, true);
                v[j].x += gk * lo[0]; v[j].y += gk * lo[1]; v[j].z += gk * hi[0]; v[j].w += gk * hi[1]; } }
        float s = 0.f;
#pragma unroll
        for (int j = 0; j < 4; ++j) s += (v[j].x * v[j].x + v[j].y * v[j].y) + (v[j].z * v[j].z + v[j].w * v[j].w);
        const float rstd = rsqrtf(wave_sum(s) * (1.f / D) + EPS);
        const f32x4* nw = (const f32x4*)F.final_norm_w + F.lane;
#pragma unroll
        for (int j = 0; j < 4; ++j) { const f32x4 w = nw[64 * j]; f32x4* dst = probe ? (f32x4*)(F.ws + WS_ACT + (size_t)row * D * 4) + F.lane : xr; dst[64 * j] = (f32x4){v[j].x * rstd * w.x, v[j].y * rstd * w.y, v[j].z * rstd * w.z, v[j].w * rstd * w.w}; }
    }
}

__device__ __forceinline__ bool refresh_ids(Frame& F) { int t = threadIdx.x; asm volatile("" : "+v"(t)); F.tid = t; F.lane = t & 63; return true; }
constexpr int N_PHASES = 10;
#ifndef NAIVE_MIXER
#define NAIVE_MIXER 0
#endif
#ifndef N_LAUNCHES
#define N_LAUNCHES 1
#endif
__global__ void __launch_bounds__(512, 2) hymba_fwd(Args args) {
    extern __shared__ __attribute__((aligned(16))) unsigned char lds_raw[];
    Frame F;
    F.lds = (LAS unsigned char*)lds_raw; F.ws = args.ws; F.tid = threadIdx.x; F.lane = F.tid & 63; F.wave = __builtin_amdgcn_readfirstlane(F.tid >> 6); F.G = gridDim.x; F.bid = blockIdx.x;
    F.x = args.in[0]; F.meta = args.in[1]; F.mix_norm_w = args.in[2]; F.w_in = args.in[3]; F.conv_w = args.in[4]; F.conv_b = args.in[5]; F.dt_bias = args.in[6]; F.a_log = args.in[7]; F.d_skip = args.in[8];
    F.ssd_norm_w = args.in[9]; F.w_decay_up = args.in[10]; F.b_decay = args.in[11]; F.gla_norm_w = args.in[12]; F.w_out = args.in[13]; F.ffn_norm_w = args.in[14]; F.w_router = args.in[15]; F.b_router = args.in[16];
    F.w_gate_up = args.in[17]; F.b_gate_up = args.in[18]; F.w_down = args.in[19]; F.b_down = args.in[20]; F.final_norm_w = args.in[21]; F.out = args.out;
    const int lo = args.ph_lo, hi = args.ph_hi;
    volatile LAS unsigned* bst = (volatile LAS unsigned*)(F.lds + LDS_BYTES - 16);
    if (F.tid < 4) bst[F.tid] = 0u;
    __syncthreads();
    XcdBarrier bar; bar.bar = (unsigned*)(F.ws + WS_CTL) + CW_BAR; bar.x = 0; bar.st = bst;
    if (hi - lo > 1) bar = xcd_barrier_post((unsigned*)(F.ws + WS_CTL) + CW_BAR, bst);
#ifndef PH_MASK
#define PH_MASK 0x3ff
#endif
#define IN(k) (((PH_MASK >> (k)) & 1) && lo <= (k) && (k) < hi && refresh_ids(F))
#ifndef DUP_MASK
#define DUP_MASK 0x0
#endif
#define DUP(k) ((DUP_MASK >> (k)) & 1)
#ifndef DUP_WHICH
#define DUP_WHICH 0
#endif
#ifndef EXTRA_BARS
#define EXTRA_BARS 0
#endif
#define SEAM(k) do { if (IN(k) && IN((k) + 1)) { xcd_barrier(bar); for (int _e = 0; _e < EXTRA_BARS; ++_e) xcd_barrier(bar); } } while (0)
    if (IN(0)) { phase_prep(F); if (DUP(0)) phase_prep(F); }
    SEAM(0);
    if (IN(1)) { phase_inproj(F, true); if (DUP(1)) phase_inproj(F, false); }
    SEAM(1);
#if NAIVE_MIXER
    if (IN(2)) phase_ssd_naive(F);
    if (IN(3)) phase_gla_naive(F);
    SEAM(3);
    if (IN(4)) phase_mixnorm(F);
    SEAM(4);
#else
    if (IN(2)) { phase_m1(F, 0); if (DUP(2)) phase_m1(F, DUP_WHICH); }
    SEAM(2);
    if (IN(3)) { phase_m2(F, 0); if (DUP(3)) phase_m2(F, 1); }
    SEAM(3);
    if (IN(4)) { phase_m3(F, 0); if (DUP(4)) phase_m3(F, DUP_WHICH); }
    SEAM(4);
#endif
    if (IN(5)) { phase_outproj(F); if (DUP(5)) phase_outproj(F); }
    SEAM(5);
    if (IN(6)) { phase_router(F, 0); if (DUP(6)) phase_router(F, 1); }
    SEAM(6);
    if (IN(7)) { phase_gateup(F); if (DUP(7)) phase_gateup(F); }
    SEAM(7);
    if (IN(8)) { if (DUP(8)) phase_down(F, DUP_WHICH); phase_down(F, 1); }
    SEAM(8);
    if (IN(9)) { if (DUP(9)) phase_combine(F, 1); phase_combine(F, 0); }
#undef SEAM
#undef IN
}

extern "C" void kernel_launch(void* const* d_in, const int* in_sizes, int n_in, void* d_out, int out_size, void* d_ws, size_t ws_size, hipStream_t stream) {
    static int grid = 0;
    if (grid == 0) {
        if (n_in != 22 || out_size != NTOK * D || ws_size < WS_END) { fprintf(stderr, "kernel_launch: unexpected shapes (n_in %d out %d ws %zu)\n", n_in, out_size, ws_size); grid = -1; return; }
        int dev = 0, cus = 0;
        if (hipGetDevice(&dev) != hipSuccess || hipDeviceGetAttribute(&cus, hipDeviceAttributeMultiprocessorCount, dev) != hipSuccess) { grid = -1; return; }
        if (hipFuncSetAttribute((const void*)hymba_fwd, hipFuncAttributeMaxDynamicSharedMemorySize, LDS_BYTES) != hipSuccess) { fprintf(stderr, "kernel_launch: hipFuncSetAttribute failed\n"); grid = -1; return; }
        int per_cu = 0;
        if (hipOccupancyMaxActiveBlocksPerMultiprocessor(&per_cu, (const void*)hymba_fwd, 512, LDS_BYTES) != hipSuccess || per_cu < 1) { fprintf(stderr, "kernel_launch: occupancy query says %d blocks per CU\n", per_cu); (void)hipGetLastError(); }
        grid = cus;
    }
    if (grid < 0) return;
    (void)hipMemsetAsync((char*)d_ws + WS_CTL, 0, CTL_ZERO_BYTES, stream);
    Args a{};
    for (int i = 0; i < 22; ++i) a.in[i] = (const float*)d_in[i];
    a.out = (float*)d_out; a.ws = (unsigned char*)d_ws;
#if N_LAUNCHES == 1
    a.ph_lo = 0; a.ph_hi = N_PHASES; hipLaunchKernelGGL(hymba_fwd, dim3(grid), dim3(512), LDS_BYTES, stream, a);
#else
    for (int ph = 0; ph < N_PHASES; ++ph) { a.ph_lo = ph; a.ph_hi = ph + 1; hipLaunchKernelGGL(hymba_fwd, dim3(grid), dim3(512), LDS_BYTES, stream, a); }
#endif
}
```
